# Optimizing an MI355X kernel written in HIP

```python
import jax, jax.numpy as jnp
from jax import lax
import numpy as np

D_MODEL = 1024
BATCH = 8
SEQ = 4096
DEPTH = 1

HEAD_DIM = 64
MOBA_HEADS = 8
MOBA_WIDTH = MOBA_HEADS * HEAD_DIM
MOBA_BLOCK = 256
MOBA_TOPK = 3
MOBA_Q_BLOCK = 64
ALIBI_MAX = 8.0
GLA_HEADS = 4
GLA_DK = 64
GLA_DV = 128
GLA_KEY_WIDTH = GLA_HEADS * GLA_DK
GLA_VAL_WIDTH = GLA_HEADS * GLA_DV
GLA_GATE_RANK = 16
GLA_GATE_TAU = 16.0
GLA_CHUNK = 64
MIX_WIDTH = MOBA_WIDTH + GLA_VAL_WIDTH
PROJ_WIDTH = 3 * MOBA_WIDTH + 2 * GLA_KEY_WIDTH + 2 * GLA_VAL_WIDTH + GLA_GATE_RANK
N_EXPERTS = 32
TOP_K = 4
D_EXPERT = D_MODEL
SWIGLU_ALPHA = 1.702
SWIGLU_LIMIT = 7.0
MOE_ROW_BLOCK = 128
PLE_DIM = 256
EPS = 1e-6

kernel_name = 'hybrid_moba_gla_moe_ple'


def rms_norm(x, g):
    xf = x.astype(jnp.float32)
    y = xf * lax.rsqrt(jnp.mean(xf * xf, axis=-1, keepdims=True) + EPS)
    return (y * g.astype(jnp.float32)).astype(x.dtype)


def moba_attention(q, k, v):
    B, H, S, Dh = q.shape
    f32 = jnp.float32
    nb = -(-S // MOBA_BLOCK)
    pad = nb * MOBA_BLOCK - S
    kb = jnp.pad(k, ((0, 0), (0, 0), (0, pad), (0, 0))).reshape(B, H, nb, MOBA_BLOCK, Dh)
    vb = jnp.pad(v, ((0, 0), (0, 0), (0, pad), (0, 0))).reshape(B, H, nb, MOBA_BLOCK, Dh)
    k_mean = jnp.mean(kb.astype(f32), axis=3)
    slopes = jnp.exp2(-ALIBI_MAX * jnp.arange(1, H + 1, dtype=f32) / H)[None, :, None, None]
    scale = Dh ** -0.5
    n_sel = min(MOBA_TOPK, nb - 1)
    nq = S // MOBA_Q_BLOCK
    q_blocks = q.reshape(B, H, nq, MOBA_Q_BLOCK, Dh).transpose(2, 0, 1, 3, 4)
    b_idx = jnp.arange(B)[:, None, None]
    h_idx = jnp.arange(H)[None, :, None]
    offs = jnp.arange(MOBA_BLOCK)

    def attend_block(args):
        qb, c = args
        qf = qb.astype(f32) * scale
        q_pos = c * MOBA_Q_BLOCK + jnp.arange(MOBA_Q_BLOCK)
        own = (c * MOBA_Q_BLOCK) // MOBA_BLOCK
        scores = []
        sel = None
        if n_sel > 0:
            gate = jnp.einsum('bhqd,bhnd->bhqn', qf, k_mean)
            gate = jnp.where(jnp.arange(nb) < own, gate, -jnp.inf)
            _, sel = lax.top_k(gate, n_sel)
            for j in range(n_sel):
                idx = sel[..., j]
                kj = kb[b_idx, h_idx, idx].astype(f32)
                s = jnp.einsum('bhqd,bhqkd->bhqk', qf, kj)
                dist = (q_pos[:, None] - (idx[..., None] * MOBA_BLOCK + offs)).astype(f32)
                s = jnp.where(j < own, s - slopes * dist, -jnp.inf)
                scores.append(s)
        ko = lax.dynamic_index_in_dim(kb, own, axis=2, keepdims=False).astype(f32)
        vo = lax.dynamic_index_in_dim(vb, own, axis=2, keepdims=False).astype(f32)
        dist = (q_pos[:, None] - (own * MOBA_BLOCK + offs)[None, :]).astype(f32)
        s = jnp.einsum('bhqd,bhkd->bhqk', qf, ko)
        s = jnp.where(dist >= 0, s - slopes * dist, -jnp.inf)
        scores.append(s)
        probs = jax.nn.softmax(jnp.concatenate(scores, axis=-1), axis=-1)
        probs = probs.reshape(B, H, MOBA_Q_BLOCK, n_sel + 1, MOBA_BLOCK)
        out = jnp.einsum('bhqk,bhkd->bhqd', probs[:, :, :, n_sel], vo)
        for j in range(n_sel):
            vj = vb[b_idx, h_idx, sel[..., j]].astype(f32)
            out = out + jnp.einsum('bhqk,bhqkd->bhqd', probs[:, :, :, j], vj)
        return out.astype(q.dtype)

    out = lax.map(attend_block, (q_blocks, jnp.arange(nq)))
    return out.transpose(1, 2, 0, 3, 4).reshape(B, H, S, Dh)


def gla_chunked(q, k, v, log_a):
    B, H, S, DK = q.shape
    DV = v.shape[-1]
    f32 = jnp.float32
    C = GLA_CHUNK
    nc = S // C
    qf = q.astype(f32).reshape(B, H, nc, C, DK) * DK ** -0.5
    kf = k.astype(f32).reshape(B, H, nc, C, DK)
    vf = v.astype(f32).reshape(B, H, nc, C, DV)
    G = jnp.cumsum(log_a.astype(f32).reshape(B, H, nc, C, DK), axis=3)
    G_last = G[:, :, :, -1:, :]
    q_dec = qf * jnp.exp(G)
    k_dec = kf * jnp.exp(-G)
    k_tail = kf * jnp.exp(G_last - G)
    causal = jnp.tril(jnp.ones((C, C), dtype=bool))
    A = jnp.where(causal, jnp.einsum('bhnqd,bhnkd->bhnqk', q_dec, k_dec), 0.0)
    o_intra = jnp.einsum('bhnqk,bhnkv->bhnqv', A, vf)
    kv = jnp.einsum('bhnkd,bhnkv->bhndv', k_tail, vf)
    decay = jnp.exp(G_last[:, :, :, 0, :])

    def step(state, inp):
        kv_c, d_c = inp
        return d_c[..., None] * state + kv_c, state

    _, s_prev = lax.scan(step, jnp.zeros((B, H, DK, DV), f32),
                         (kv.transpose(2, 0, 1, 3, 4), decay.transpose(2, 0, 1, 3)))
    s_prev = s_prev.transpose(1, 2, 0, 3, 4)
    o_inter = jnp.einsum('bhnqd,bhndv->bhnqv', q_dec, s_prev)
    return (o_intra + o_inter).reshape(B, H, S, DV).astype(v.dtype)


def clamped_swiglu(hid):
    x_glu = jnp.minimum(hid[..., ::2], SWIGLU_LIMIT)
    x_lin = jnp.clip(hid[..., 1::2], -SWIGLU_LIMIT, SWIGLU_LIMIT)
    return x_glu * jax.nn.sigmoid(SWIGLU_ALPHA * x_glu) * (x_lin + 1.0)


def moe_ffn(h, w_router, b_router, w1, b1, w2, b2):
    T, D = h.shape
    M = MOE_ROW_BLOCK
    logits = (h @ w_router + b_router).astype(jnp.float32)
    top_vals, top_idx = lax.top_k(logits, TOP_K)
    gates = jax.nn.softmax(top_vals, axis=-1).astype(h.dtype)
    n_assign = T * TOP_K
    flat_e = top_idx.reshape(-1)
    order = jnp.argsort(flat_e, stable=True)
    sorted_e = flat_e[order]
    sorted_tok = order // TOP_K
    sorted_gate = gates.reshape(-1)[order]
    counts = jnp.bincount(flat_e, length=N_EXPERTS)
    padded = (counts + M - 1) // M * M
    grp_start = jnp.cumsum(counts) - counts
    pad_end = jnp.cumsum(padded)
    pad_start = pad_end - padded
    dest = pad_start[sorted_e] + jnp.arange(n_assign) - grp_start[sorted_e]
    n_blocks = -(-n_assign // M) + N_EXPERTS
    n_rows = n_blocks * M
    row_tok = jnp.zeros((n_rows,), jnp.int32).at[dest].set(sorted_tok.astype(jnp.int32))
    row_gate = jnp.zeros((n_rows,), h.dtype).at[dest].set(sorted_gate)
    block_expert = jnp.minimum(jnp.searchsorted(pad_end, jnp.arange(n_blocks) * M, side='right'),
                               N_EXPERTS - 1)
    x_rows = h[row_tok].reshape(n_blocks, M, D)

    def expert_block(args):
        xb, e = args
        hid = xb @ w1[e] + b1[e]
        return clamped_swiglu(hid) @ w2[e] + b2[e]

    y = lax.map(expert_block, (x_rows, block_expert)).reshape(n_rows, D)
    return jnp.zeros_like(h).at[row_tok].add(y * row_gate[:, None])


def setup_inputs(seed: int = 0) -> dict:
    key = jax.random.key(seed)
    ks = jax.random.split(key, 19)
    L = DEPTH

    def nrm(k, shape, scale):
        return jax.random.normal(k, shape, jnp.float32) * scale

    return {
        'x': nrm(ks[0], (BATCH, SEQ, D_MODEL), 1.0),
        'p': nrm(ks[1], (DEPTH, BATCH, SEQ, PLE_DIM), 1.0),
        'g_mix': 1.0 + nrm(ks[2], (L, D_MODEL), 0.01),
        'w_in': nrm(ks[3], (L, D_MODEL, PROJ_WIDTH), D_MODEL ** -0.5),
        'w_gla_gate': nrm(ks[4], (L, GLA_GATE_RANK, GLA_KEY_WIDTH), GLA_GATE_RANK ** -0.5),
        'b_gla_gate': nrm(ks[5], (L, GLA_KEY_WIDTH), 0.1),
        'g_gla_norm': 1.0 + nrm(ks[6], (L, GLA_DV), 0.01),
        'w_out': nrm(ks[7], (L, MIX_WIDTH, D_MODEL), MIX_WIDTH ** -0.5),
        'g_ffn': 1.0 + nrm(ks[8], (L, D_MODEL), 0.01),
        'w_router': nrm(ks[9], (L, D_MODEL, N_EXPERTS), D_MODEL ** -0.5),
        'b_router': nrm(ks[10], (L, N_EXPERTS), 0.01),
        'w1': nrm(ks[11], (L, N_EXPERTS, D_MODEL, 2 * D_EXPERT), D_MODEL ** -0.5),
        'b1': nrm(ks[12], (L, N_EXPERTS, 2 * D_EXPERT), 0.01),
        'w2': nrm(ks[13], (L, N_EXPERTS, D_EXPERT, D_MODEL), D_EXPERT ** -0.5),
        'b2': nrm(ks[14], (L, N_EXPERTS, D_MODEL), 0.01),
        'w_ple_gate': nrm(ks[15], (L, D_MODEL, D_MODEL), D_MODEL ** -0.5),
        'w_ple_proj': nrm(ks[16], (L, PLE_DIM, D_MODEL), PLE_DIM ** -0.5),
        'g_ple': 1.0 + nrm(ks[17], (L, D_MODEL), 0.01),
        'g_final': 1.0 + nrm(ks[18], (D_MODEL,), 0.01),
    }


def reference(x, p, g_mix, w_in, w_gla_gate, b_gla_gate, g_gla_norm, w_out, g_ffn,
              w_router, b_router, w1, b1, w2, b2, w_ple_gate, w_ple_proj, g_ple, g_final):
    B, S, D = x.shape
    splits = list(np.cumsum([MOBA_WIDTH, MOBA_WIDTH, MOBA_WIDTH, GLA_KEY_WIDTH, GLA_KEY_WIDTH,
                             GLA_VAL_WIDTH, GLA_VAL_WIDTH])[:])
    splits = [int(s) for s in splits]
    h = x
    for i in range(DEPTH):
        a = rms_norm(h, g_mix[i])
        proj = a @ w_in[i]
        qa, ka, va, qg, kg, vg, rg, ag = jnp.split(proj, splits, axis=-1)
        to_heads = lambda t, nh: t.reshape(B, S, nh, -1).transpose(0, 2, 1, 3)
        o_moba = moba_attention(to_heads(qa, MOBA_HEADS), to_heads(ka, MOBA_HEADS),
                                to_heads(va, MOBA_HEADS))
        o_moba = o_moba.transpose(0, 2, 1, 3).reshape(B, S, MOBA_WIDTH)
        log_a = jax.nn.log_sigmoid((ag @ w_gla_gate[i] + b_gla_gate[i]).astype(jnp.float32)) / GLA_GATE_TAU
        o_gla = gla_chunked(to_heads(qg, GLA_HEADS), to_heads(kg, GLA_HEADS),
                            to_heads(vg, GLA_HEADS), to_heads(log_a, GLA_HEADS))
        o_gla = rms_norm(o_gla, g_gla_norm[i]).transpose(0, 2, 1, 3).reshape(B, S, GLA_VAL_WIDTH)
        o_gla = o_gla * jax.nn.silu(rg)
        h = h + jnp.concatenate([o_moba, o_gla], axis=-1) @ w_out[i]
        f = rms_norm(h, g_ffn[i]).reshape(B * S, D)
        h = h + moe_ffn(f, w_router[i], b_router[i], w1[i], b1[i], w2[i], b2[i]).reshape(B, S, D)
        ple = rms_norm(p[i] @ w_ple_proj[i], g_ple[i])
        h = h + jax.nn.sigmoid(h @ w_ple_gate[i]) * ple
    return rms_norm(h, g_final)
```

```cpp
#include <hip/hip_runtime.h>
#include <cstdio>
#include <cstdint>

namespace nv {
constexpr int B = 8, S = 4096, D = 1024, T = B * S;
constexpr int HM = 8, NB = S / 256;
constexpr int HG = 4;
constexpr int PW = 3088;
constexpr int NE = 32;
constexpr float EPS = 1e-6f;
constexpr int C_QA = 0, C_KA = 512, C_VA = 1024, C_QG = 1536, C_KG = 1792, C_VG = 2048, C_RG = 2560, C_AG = 3072;

__global__ __launch_bounds__(256) void k_rmsnorm(const float* __restrict__ x, const float* __restrict__ g, float* __restrict__ y, long long rows_, long long Dn_) {
    const int rows = (int)rows_, Dn = (int)Dn_;
    const int row = blockIdx.x * 4 + (threadIdx.x >> 6), lane = threadIdx.x & 63;
    if (row >= rows) return;
    const float* xr = x + (size_t)row * Dn; float s = 0.f;
    for (int c = lane; c < Dn; c += 64) { const float v = xr[c]; s += v * v; }
    for (int o = 32; o >= 1; o >>= 1) s += __shfl_xor(s, o);
    const float r = 1.0f / sqrtf(s / (float)Dn + EPS);
    for (int c = lane; c < Dn; c += 64) y[(size_t)row * Dn + c] = xr[c] * r * g[c];
}

struct TileInfo { int row0, nrows, e, base; };
template <class RM, class EP>
__global__ __launch_bounds__(256) void k_sgemm(const float* __restrict__ A, const float* __restrict__ Bm, long long lda_, long long ldb_, long long K_, long long N_, RM rm, EP ep) {
    const int lda = (int)lda_, ldb = (int)ldb_, K = (int)K_, N = (int)N_;
    __shared__ float As[16][68]; __shared__ float Bs[16][68];
    TileInfo ti; if (!rm.tile((int)blockIdx.y, ti)) return;
    const float* Bp = Bm + rm.b_off(ti);
    const int tid = threadIdx.x, n0 = blockIdx.x * 64;
    const int ar = tid >> 2, ak = (tid & 3) * 4;
    const long asrc = (ar < ti.nrows) ? rm.src(ti, ar) : -1;
    const int bk = tid >> 4, bn = (tid & 15) * 4;
    const bool bok = (n0 + bn) < N;
    float acc[4][4];
#pragma unroll
    for (int i = 0; i < 4; ++i)
#pragma unroll
        for (int j = 0; j < 4; ++j) acc[i][j] = 0.f;
    const int ty = tid >> 4, tx = tid & 15;
    for (int k0 = 0; k0 < K; k0 += 16) {
        float4 av = make_float4(0.f, 0.f, 0.f, 0.f), bv = make_float4(0.f, 0.f, 0.f, 0.f);
        if (asrc >= 0) av = *(const float4*)(A + (size_t)asrc * lda + k0 + ak);
        if (bok) bv = *(const float4*)(Bp + (size_t)(k0 + bk) * ldb + n0 + bn);
        __syncthreads();
        As[ak + 0][ar] = av.x; As[ak + 1][ar] = av.y; As[ak + 2][ar] = av.z; As[ak + 3][ar] = av.w;
        *(float4*)&Bs[bk][bn] = bv;
        __syncthreads();
#pragma unroll
        for (int kk = 0; kk < 16; ++kk) {
            const float4 a4 = *(const float4*)&As[kk][ty * 4]; const float4 b4 = *(const float4*)&Bs[kk][tx * 4];
            const float a[4] = {a4.x, a4.y, a4.z, a4.w}, b[4] = {b4.x, b4.y, b4.z, b4.w};
#pragma unroll
            for (int i = 0; i < 4; ++i)
#pragma unroll
                for (int j = 0; j < 4; ++j) acc[i][j] += a[i] * b[j];
        }
    }
    const int c = n0 + tx * 4;
    if (c < N) {
#pragma unroll
        for (int i = 0; i < 4; ++i) { const int r = ty * 4 + i; if (r < ti.nrows) ep(ti, r, c, acc[i][0], acc[i][1], acc[i][2], acc[i][3]); }
    }
}
struct RMDense { long long M; __device__ bool tile(int mt, TileInfo& ti) const { ti.row0 = mt * 64; ti.nrows = 64; ti.e = 0; ti.base = 0; return ti.row0 < M; }
    __device__ long src(const TileInfo& ti, int r) const { return ti.row0 + r; } __device__ size_t b_off(const TileInfo&) const { return 0; } };
struct EpStore { float* C; long long ldc; __device__ void operator()(const TileInfo& ti, int r, int c, float v0, float v1, float v2, float v3) const { *(float4*)(C + (size_t)(ti.row0 + r) * ldc + c) = make_float4(v0, v1, v2, v3); } };
struct EpAddRes { const float* R; float* C; long long ldc; __device__ void operator()(const TileInfo& ti, int r, int c, float v0, float v1, float v2, float v3) const {
    const size_t o = (size_t)(ti.row0 + r) * ldc + c; const float4 x = *(const float4*)(R + o); *(float4*)(C + o) = make_float4(x.x + v0, x.y + v1, x.z + v2, x.w + v3); } };
struct EpBias { float* C; long long ldc; const float* bias; __device__ void operator()(const TileInfo& ti, int r, int c, float v0, float v1, float v2, float v3) const {
    *(float4*)(C + (size_t)(ti.row0 + r) * ldc + c) = make_float4(v0 + bias[c], v1 + bias[c + 1], v2 + bias[c + 2], v3 + bias[c + 3]); } };
__device__ __forceinline__ float sigm(float x) { return 1.0f / (1.0f + expf(-x)); }
struct EpPle { const float* h2; const float* ple; float* h3; __device__ void operator()(const TileInfo& ti, int r, int c, float v0, float v1, float v2, float v3) const {
    const size_t o = (size_t)(ti.row0 + r) * D + c; const float4 h = *(const float4*)(h2 + o), p = *(const float4*)(ple + o);
    *(float4*)(h3 + o) = make_float4(h.x + sigm(v0) * p.x, h.y + sigm(v1) * p.y, h.z + sigm(v2) * p.z, h.w + sigm(v3) * p.w); } };

struct RMMoe { const int* cnt; const int* list; long long gather;
    __device__ bool tile(int mt, TileInfo& ti) const { int tb = 0, rb = 0;
        for (int e = 0; e < NE; ++e) { const int c = cnt[e], nt = (c + 63) >> 6; if (mt < tb + nt) { ti.e = e; ti.row0 = (mt - tb) * 64; ti.nrows = min(64, c - ti.row0); ti.base = rb; return true; } tb += nt; rb += c; }
        return false; }
    __device__ long src(const TileInfo& ti, int r) const { return gather ? (long)list[(size_t)ti.e * T + ti.row0 + r] : (long)(ti.base + ti.row0 + r); }
    __device__ size_t b_off(const TileInfo& ti) const { return gather ? (size_t)ti.e * 1024 * 2048 : (size_t)ti.e * 1024 * 1024; } };
__device__ __forceinline__ float swiglu1(float a, float b) { const float g = fminf(a, 7.0f), l = fminf(fmaxf(b, -7.0f), 7.0f); return g * sigm(1.702f * g) * (l + 1.0f); }
struct EpSwiglu { float* act; const float* b1; __device__ void operator()(const TileInfo& ti, int r, int c, float v0, float v1, float v2, float v3) const {
    const float* bb = b1 + (size_t)ti.e * 2048 + c; float* o = act + (size_t)(ti.base + ti.row0 + r) * 1024 + (c >> 1);
    o[0] = swiglu1(v0 + bb[0], v1 + bb[1]); o[1] = swiglu1(v2 + bb[2], v3 + bb[3]); } };
struct EpMoeOut { float* h2; const float* b2; const int* list; const float* gate; long long slot; __device__ void operator()(const TileInfo& ti, int r, int c, float v0, float v1, float v2, float v3) const {
    const int tok = list[(size_t)ti.e * T + ti.row0 + r]; const float g = gate[tok * 4 + slot]; const float* bb = b2 + (size_t)ti.e * 1024 + c; float* o = h2 + (size_t)tok * D + c;
    o[0] += g * (v0 + bb[0]); o[1] += g * (v1 + bb[1]); o[2] += g * (v2 + bb[2]); o[3] += g * (v3 + bb[3]); } };

__global__ __launch_bounds__(64) void k_kmean(const float* __restrict__ proj, float* __restrict__ kmean) {
    const int n = blockIdx.x % NB, h = (blockIdx.x / NB) % HM, b = blockIdx.x / (NB * HM), d = threadIdx.x;
    float s = 0.f;
    for (int k = 0; k < 256; ++k) s += proj[((size_t)b * S + n * 256 + k) * PW + C_KA + h * 64 + d];
    kmean[(size_t)blockIdx.x * 64 + d] = s * (1.0f / 256.0f);
}
__global__ __launch_bounds__(64) void k_moba(const float* __restrict__ proj, const float* __restrict__ kmean, float* __restrict__ mix) {
    const int qc = blockIdx.x % (S / 64), h = (blockIdx.x / (S / 64)) % HM, b = blockIdx.x / ((S / 64) * HM);
    const int qpos = qc * 64 + threadIdx.x; const size_t t = (size_t)b * S + qpos;
    float q[64];
    { const float* qp = proj + t * PW + C_QA + h * 64;
#pragma unroll
      for (int d = 0; d < 64; ++d) q[d] = qp[d] * 0.125f; }
    const int own = qpos >> 8;
    float g0 = -INFINITY, g1 = -INFINITY, g2 = -INFINITY; int i0 = -1, i1 = -1, i2 = -1;
    for (int n = 0; n < own; ++n) {
        const float* km = kmean + (((size_t)b * HM + h) * NB + n) * 64; float s = 0.f;
#pragma unroll
        for (int d = 0; d < 64; ++d) s += q[d] * km[d];
        if (s > g0) { g2 = g1; i2 = i1; g1 = g0; i1 = i0; g0 = s; i0 = n; }
        else if (s > g1) { g2 = g1; i2 = i1; g1 = s; i1 = n; }
        else if (s > g2) { g2 = s; i2 = n; }
    }
    const float slope = exp2f(-(float)(h + 1));
    float m = -INFINITY, l = 0.f; float o[64];
#pragma unroll
    for (int d = 0; d < 64; ++d) o[d] = 0.f;
    for (int j = 0; j < 4; ++j) {
        const int nblk = (j == 0) ? i0 : (j == 1) ? i1 : (j == 2) ? i2 : own;
        if (nblk < 0) continue;
        const int kend = (j < 3) ? 256 : (qpos - own * 256 + 1);
        for (int kk = 0; kk < kend; ++kk) {
            const int kpos = nblk * 256 + kk; const float* kp = proj + ((size_t)b * S + kpos) * PW + C_KA + h * 64; const float* vp = kp + 512;
            float s = 0.f;
#pragma unroll
            for (int d = 0; d < 64; ++d) s += q[d] * kp[d];
            s -= slope * (float)(qpos - kpos);
            const float mn = fmaxf(m, s), corr = expf(m - mn), pe = expf(s - mn);
            l = l * corr + pe;
#pragma unroll
            for (int d = 0; d < 64; ++d) o[d] = o[d] * corr + pe * vp[d];
            m = mn;
        }
    }
    const float inv = 1.0f / l;
#pragma unroll
    for (int d = 0; d < 64; ++d) mix[t * D + h * 64 + d] = o[d] * inv;
}

__global__ __launch_bounds__(256) void k_gla_gate(const float* __restrict__ proj, const float* __restrict__ wg, const float* __restrict__ bg, float* __restrict__ adec) {
    const size_t t = blockIdx.x; const int j = threadIdx.x;
    float z = bg[j];
#pragma unroll
    for (int r = 0; r < 16; ++r) z += proj[t * PW + C_AG + r] * wg[r * 256 + j];
    const float ls = fminf(z, 0.f) - log1pf(expf(-fabsf(z)));
    adec[t * 256 + j] = expf(ls * (1.0f / 16.0f));
}
__global__ __launch_bounds__(128) void k_gla_rec(const float* __restrict__ proj, const float* __restrict__ adec, float* __restrict__ ogla) {
    const int b = blockIdx.x / HG, h = blockIdx.x % HG, dv = threadIdx.x;
    float s[64];
#pragma unroll
    for (int i = 0; i < 64; ++i) s[i] = 0.f;
    for (int t = 0; t < S; ++t) {
        const size_t row = (size_t)b * S + t; const float* qp = proj + row * PW + C_QG + h * 64; const float* kp = proj + row * PW + C_KG + h * 64; const float* ap = adec + row * 256 + h * 64;
        const float v = proj[row * PW + C_VG + h * 128 + dv]; float o = 0.f;
#pragma unroll
        for (int i = 0; i < 64; ++i) { s[i] = ap[i] * s[i] + kp[i] * v; o += qp[i] * s[i]; }
        ogla[row * 512 + h * 128 + dv] = o * 0.125f;
    }
}
__global__ __launch_bounds__(256) void k_gla_post(const float* __restrict__ ogla, const float* __restrict__ g, const float* __restrict__ proj, float* __restrict__ mix) {
    const int row = blockIdx.x * 4 + (threadIdx.x >> 6), lane = threadIdx.x & 63;
    const size_t t = row >> 2; const int h = row & 3;
    const float* xr = ogla + (size_t)row * 128; const float a = xr[lane], b = xr[lane + 64]; float s = a * a + b * b;
    for (int o = 32; o >= 1; o >>= 1) s += __shfl_xor(s, o);
    const float r = 1.0f / sqrtf(s / 128.0f + EPS);
    const float r0 = proj[t * PW + C_RG + h * 128 + lane], r1 = proj[t * PW + C_RG + h * 128 + lane + 64];
    mix[t * D + 512 + h * 128 + lane] = a * r * g[lane] * (r0 * sigm(r0));
    mix[t * D + 512 + h * 128 + lane + 64] = b * r * g[lane + 64] * (r1 * sigm(r1));
}

__global__ __launch_bounds__(256) void k_topk(const float* __restrict__ logits, int* __restrict__ tope, float* __restrict__ gate) {
    const int t = blockIdx.x * 256 + threadIdx.x; if (t >= T) return;
    float v[32];
#pragma unroll
    for (int e = 0; e < 32; ++e) v[e] = logits[(size_t)t * 32 + e];
    float tv[4]; int te[4]; unsigned used = 0u;
#pragma unroll
    for (int j = 0; j < 4; ++j) { float best = -INFINITY; int bi = 0;
#pragma unroll
        for (int e = 0; e < 32; ++e) { const bool ok = !((used >> e) & 1u) && v[e] > best; best = ok ? v[e] : best; bi = ok ? e : bi; }
        used |= 1u << bi; tv[j] = best; te[j] = bi; }
    const float e0 = 1.0f, e1 = expf(tv[1] - tv[0]), e2 = expf(tv[2] - tv[0]), e3 = expf(tv[3] - tv[0]); const float inv = 1.0f / (e0 + e1 + e2 + e3);
    tope[t * 4 + 0] = te[0]; tope[t * 4 + 1] = te[1]; tope[t * 4 + 2] = te[2]; tope[t * 4 + 3] = te[3];
    gate[t * 4 + 0] = e0 * inv; gate[t * 4 + 1] = e1 * inv; gate[t * 4 + 2] = e2 * inv; gate[t * 4 + 3] = e3 * inv;
}
__global__ __launch_bounds__(64) void k_sort_slot(const int* __restrict__ tope, long long slot_, int* __restrict__ list, int* __restrict__ cnt) {
    const int slot = (int)slot_;
    const int e = blockIdx.x, lane = threadIdx.x; int base = 0;
    for (int t0 = 0; t0 < T; t0 += 64) { const int t = t0 + lane; const bool hit = tope[t * 4 + slot] == e; const unsigned long long m = __ballot(hit);
        const int pos = base + __popcll(m & ((1ull << lane) - 1ull)); if (hit) list[(size_t)e * T + pos] = t; base += __popcll(m); }
    if (lane == 0) cnt[e] = base;
}
}

extern "C" void kernel_launch(void* const* d_in, const int* in_sizes, int n_in, void* d_out, int out_size, void* d_ws, size_t ws_size, hipStream_t stream) {
    using namespace nv;
    const float* x = (const float*)d_in[0]; const float* p = (const float*)d_in[1]; const float* g_mix = (const float*)d_in[2]; const float* w_in = (const float*)d_in[3];
    const float* w_gg = (const float*)d_in[4]; const float* b_gg = (const float*)d_in[5]; const float* g_gn = (const float*)d_in[6]; const float* w_out = (const float*)d_in[7];
    const float* g_ffn = (const float*)d_in[8]; const float* w_router = (const float*)d_in[9]; const float* b_router = (const float*)d_in[10]; const float* w1 = (const float*)d_in[11];
    const float* b1 = (const float*)d_in[12]; const float* w2 = (const float*)d_in[13]; const float* b2 = (const float*)d_in[14]; const float* w_pg = (const float*)d_in[15];
    const float* w_pp = (const float*)d_in[16]; const float* g_ple = (const float*)d_in[17]; const float* g_final = (const float*)d_in[18];
    float* out = (float*)d_out;
    constexpr size_t MiB = 1u << 20;
    if (ws_size < 1000 * MiB || n_in != 19) { fprintf(stderr, "kernel_launch: unexpected ws_size %zu / n_in %d\n", ws_size, n_in); return; }
    char* ws = (char*)d_ws;
    float* R0 = (float*)(ws + 0 * MiB);
    float* R1 = (float*)(ws + 128 * MiB);
    float* R2 = (float*)(ws + 516 * MiB);
    float* R3 = (float*)(ws + 644 * MiB);
    float* ADEC = (float*)(ws + 772 * MiB);
    float* OGLA = (float*)(ws + 804 * MiB);
    float* KMEAN = (float*)(ws + 868 * MiB);
    float* LOGITS = (float*)(ws + 869 * MiB);
    int* TOPE = (int*)(ws + 873 * MiB);
    float* GATE = (float*)(ws + 874 * MiB);
    int* LIST = (int*)(ws + 875 * MiB);
    int* CNT = (int*)(ws + 879 * MiB);
    k_rmsnorm<<<T / 4, 256, 0, stream>>>(x, g_mix, R0, (long long)T, (long long)D);
    { RMDense rm{(long long)T}; EpStore ep{R1, PW}; k_sgemm<<<dim3((PW + 63) / 64, T / 64), 256, 0, stream>>>(R0, w_in, (long long)D, (long long)PW, (long long)D, (long long)PW, rm, ep); }
    k_kmean<<<B * HM * NB, 64, 0, stream>>>(R1, KMEAN);
    k_moba<<<B * HM * (S / 64), 64, 0, stream>>>(R1, KMEAN, R2);
    k_gla_gate<<<T, 256, 0, stream>>>(R1, w_gg, b_gg, ADEC);
    k_gla_rec<<<B * HG, 128, 0, stream>>>(R1, ADEC, OGLA);
    k_gla_post<<<T, 256, 0, stream>>>(OGLA, g_gn, R1, R2);
    { RMDense rm{(long long)T}; EpAddRes ep{x, R3, D}; k_sgemm<<<dim3(D / 64, T / 64), 256, 0, stream>>>(R2, w_out, (long long)D, (long long)D, (long long)D, (long long)D, rm, ep); }
    k_rmsnorm<<<T / 4, 256, 0, stream>>>(R3, g_ffn, R0, (long long)T, (long long)D);
    { RMDense rm{(long long)T}; EpBias ep{LOGITS, 32, b_router}; k_sgemm<<<dim3(1, T / 64), 256, 0, stream>>>(R0, w_router, (long long)D, 32LL, (long long)D, 32LL, rm, ep); }
    k_topk<<<T / 256, 256, 0, stream>>>(LOGITS, TOPE, GATE);
    (void)hipMemcpyAsync(R2, R3, (size_t)T * D * 4, hipMemcpyDeviceToDevice, stream);
    float* ACT = R1;
    for (int slot = 0; slot < 4; ++slot) {
        k_sort_slot<<<NE, 64, 0, stream>>>(TOPE, (long long)slot, LIST, CNT);
        { RMMoe rm{CNT, LIST, 1}; EpSwiglu ep{ACT, b1}; k_sgemm<<<dim3(2048 / 64, T / 64 + NE), 256, 0, stream>>>(R0, w1, (long long)D, 2048LL, (long long)D, 2048LL, rm, ep); }
        { RMMoe rm{CNT, LIST, 0}; EpMoeOut ep{R2, b2, LIST, GATE, (long long)slot}; k_sgemm<<<dim3(1024 / 64, T / 64 + NE), 256, 0, stream>>>(ACT, w2, 1024LL, 1024LL, 1024LL, 1024LL, rm, ep); }
    }
    float* PPRE = R1 + (size_t)T * D;
    { RMDense rm{(long long)T}; EpStore ep{PPRE, D}; k_sgemm<<<dim3(D / 64, T / 64), 256, 0, stream>>>(p, w_pp, 256LL, (long long)D, 256LL, (long long)D, rm, ep); }
    k_rmsnorm<<<T / 4, 256, 0, stream>>>(PPRE, g_ple, R0, (long long)T, (long long)D);
    { RMDense rm{(long long)T}; EpPle ep{R2, R0, R3}; k_sgemm<<<dim3(D / 64, T / 64), 256, 0, stream>>>(R2, w_pg, (long long)D, (long long)D, (long long)D, (long long)D, rm, ep); }
    k_rmsnorm<<<T / 4, 256, 0, stream>>>(R3, g_final, out, (long long)T, (long long)D);
}
```

```cpp
#include <hip/hip_runtime.h>
#include <cstdio>
#include <cstdint>

typedef unsigned short bf16_t;
__device__ __forceinline__ unsigned f2bf(float f) { unsigned u = __builtin_bit_cast(unsigned, f); return (u + 0x7fffu + ((u >> 16) & 1u)) >> 16; }
__device__ __forceinline__ float bf2f(bf16_t b) { return __uint_as_float(((unsigned)b) << 16); }

__device__ __forceinline__ int mk_lane_id() { return (int)__builtin_amdgcn_mbcnt_hi(~0u, __builtin_amdgcn_mbcnt_lo(~0u, 0u)); }
namespace nv {
constexpr int B = 8, S = 4096, D = 1024, T = B * S;
constexpr int HM = 8, NB = S / 256;
constexpr int HG = 4;
constexpr int PW = 3088;
constexpr int NE = 32;
constexpr float EPS = 1e-6f;
constexpr int C_QA = 0, C_KA = 512, C_VA = 1024, C_QG = 1536, C_KG = 1792, C_VG = 2048, C_RG = 2560, C_AG = 3072;

__device__ __forceinline__ float ldf(const float* p, size_t i) { return p[i]; }
__device__ __forceinline__ float ldf(const bf16_t* p, size_t i) { return bf2f(p[i]); }
__device__ __forceinline__ void stf(float* p, size_t i, float v) { p[i] = v; }
__device__ __forceinline__ void stf(bf16_t* p, size_t i, float v) { p[i] = (bf16_t)f2bf(v); }
__device__ __forceinline__ float4 ld4(const float* p) { return *(const float4*)p; }
__device__ __forceinline__ float4 ld4(const bf16_t* p) { const uint2 u = *(const uint2*)p; return make_float4(__uint_as_float(u.x << 16), __uint_as_float(u.x & 0xffff0000u), __uint_as_float(u.y << 16), __uint_as_float(u.y & 0xffff0000u)); }

template <class TI>
__global__ __launch_bounds__(256) void k_rmsnorm(const TI* __restrict__ x, const float* __restrict__ g, float* __restrict__ y, long long rows_, long long Dn_) {
    const int rows = (int)rows_, Dn = (int)Dn_;
    const int row = blockIdx.x * 4 + (threadIdx.x >> 6), lane = threadIdx.x & 63;
    if (row >= rows) return;
    const TI* xr = x + (size_t)row * Dn; float s = 0.f;
    for (int c = lane; c < Dn; c += 64) { const float v = ldf(xr, c); s += v * v; }
    for (int o = 32; o >= 1; o >>= 1) s += __shfl_xor(s, o);
    const float r = 1.0f / sqrtf(s / (float)Dn + EPS);
    for (int c = lane; c < Dn; c += 64) y[(size_t)row * Dn + c] = ldf(xr, c) * r * g[c];
}

struct TileInfo { int row0, nrows, e, base; };
template <class TA, class RM, class EP>
__global__ __launch_bounds__(256) void k_sgemm(const TA* __restrict__ A, const float* __restrict__ Bm, long long lda_, long long ldb_, long long K_, long long N_, RM rm, EP ep) {
    const int lda = (int)lda_, ldb = (int)ldb_, K = (int)K_, N = (int)N_;
    __shared__ float As[16][68]; __shared__ float Bs[16][68];
    TileInfo ti; if (!rm.tile((int)blockIdx.y, ti)) return;
    const float* Bp = Bm + rm.b_off(ti);
    const int tid = threadIdx.x, n0 = blockIdx.x * 64;
    const int ar = tid >> 2, ak = (tid & 3) * 4;
    const long asrc = (ar < ti.nrows) ? rm.src(ti, ar) : -1;
    const int bk = tid >> 4, bn = (tid & 15) * 4;
    const bool bok = (n0 + bn) < N;
    float acc[4][4];
#pragma unroll
    for (int i = 0; i < 4; ++i)
#pragma unroll
        for (int j = 0; j < 4; ++j) acc[i][j] = 0.f;
    const int ty = tid >> 4, tx = tid & 15;
    for (int k0 = 0; k0 < K; k0 += 16) {
        float4 av = make_float4(0.f, 0.f, 0.f, 0.f), bv = make_float4(0.f, 0.f, 0.f, 0.f);
        if (asrc >= 0) av = ld4(A + (size_t)asrc * lda + k0 + ak);
        if (bok) bv = *(const float4*)(Bp + (size_t)(k0 + bk) * ldb + n0 + bn);
        __syncthreads();
        As[ak + 0][ar] = av.x; As[ak + 1][ar] = av.y; As[ak + 2][ar] = av.z; As[ak + 3][ar] = av.w;
        *(float4*)&Bs[bk][bn] = bv;
        __syncthreads();
#pragma unroll
        for (int kk = 0; kk < 16; ++kk) {
            const float4 a4 = *(const float4*)&As[kk][ty * 4]; const float4 b4 = *(const float4*)&Bs[kk][tx * 4];
            const float a[4] = {a4.x, a4.y, a4.z, a4.w}, b[4] = {b4.x, b4.y, b4.z, b4.w};
#pragma unroll
            for (int i = 0; i < 4; ++i)
#pragma unroll
                for (int j = 0; j < 4; ++j) acc[i][j] += a[i] * b[j];
        }
    }
    const int c = n0 + tx * 4;
    if (c < N) {
#pragma unroll
        for (int i = 0; i < 4; ++i) { const int r = ty * 4 + i; if (r < ti.nrows) ep(ti, r, c, acc[i][0], acc[i][1], acc[i][2], acc[i][3]); }
    }
}
struct RMDense { long long M; __device__ bool tile(int mt, TileInfo& ti) const { ti.row0 = mt * 64; ti.nrows = 64; ti.e = 0; ti.base = 0; return ti.row0 < M; }
    __device__ long src(const TileInfo& ti, int r) const { return ti.row0 + r; } __device__ size_t b_off(const TileInfo&) const { return 0; } };
struct EpStore { float* C; long long ldc; __device__ void operator()(const TileInfo& ti, int r, int c, float v0, float v1, float v2, float v3) const { *(float4*)(C + (size_t)(ti.row0 + r) * ldc + c) = make_float4(v0, v1, v2, v3); } };
struct EpAddRes { const float* R; float* C; long long ldc; __device__ void operator()(const TileInfo& ti, int r, int c, float v0, float v1, float v2, float v3) const {
    const size_t o = (size_t)(ti.row0 + r) * ldc + c; const float4 x = *(const float4*)(R + o); *(float4*)(C + o) = make_float4(x.x + v0, x.y + v1, x.z + v2, x.w + v3); } };
struct EpBias { float* C; long long ldc; const float* bias; __device__ void operator()(const TileInfo& ti, int r, int c, float v0, float v1, float v2, float v3) const {
    *(float4*)(C + (size_t)(ti.row0 + r) * ldc + c) = make_float4(v0 + bias[c], v1 + bias[c + 1], v2 + bias[c + 2], v3 + bias[c + 3]); } };
__device__ __forceinline__ float sigm(float x) { return 1.0f / (1.0f + expf(-x)); }
struct EpPle { const float* h2; const float* ple; float* h3; __device__ void operator()(const TileInfo& ti, int r, int c, float v0, float v1, float v2, float v3) const {
    const size_t o = (size_t)(ti.row0 + r) * D + c; const float4 h = *(const float4*)(h2 + o), p = *(const float4*)(ple + o);
    *(float4*)(h3 + o) = make_float4(h.x + sigm(v0) * p.x, h.y + sigm(v1) * p.y, h.z + sigm(v2) * p.z, h.w + sigm(v3) * p.w); } };

struct RMMoe { const int* cnt; const int* list; long long gather;
    __device__ bool tile(int mt, TileInfo& ti) const { int tb = 0, rb = 0;
        for (int e = 0; e < NE; ++e) { const int c = cnt[e], nt = (c + 63) >> 6; if (mt < tb + nt) { ti.e = e; ti.row0 = (mt - tb) * 64; ti.nrows = min(64, c - ti.row0); ti.base = rb; return true; } tb += nt; rb += c; }
        return false; }
    __device__ long src(const TileInfo& ti, int r) const { return gather ? (long)list[(size_t)ti.e * T + ti.row0 + r] : (long)(ti.base + ti.row0 + r); }
    __device__ size_t b_off(const TileInfo& ti) const { return gather ? (size_t)ti.e * 1024 * 2048 : (size_t)ti.e * 1024 * 1024; } };
__device__ __forceinline__ float swiglu1(float a, float b) { const float g = fminf(a, 7.0f), l = fminf(fmaxf(b, -7.0f), 7.0f); return g * sigm(1.702f * g) * (l + 1.0f); }
struct EpSwiglu { float* act; const float* b1; __device__ void operator()(const TileInfo& ti, int r, int c, float v0, float v1, float v2, float v3) const {
    const float* bb = b1 + (size_t)ti.e * 2048 + c; float* o = act + (size_t)(ti.base + ti.row0 + r) * 1024 + (c >> 1);
    o[0] = swiglu1(v0 + bb[0], v1 + bb[1]); o[1] = swiglu1(v2 + bb[2], v3 + bb[3]); } };
struct EpMoeOut { float* h2; const float* b2; const int* list; const float* gate; long long slot; __device__ void operator()(const TileInfo& ti, int r, int c, float v0, float v1, float v2, float v3) const {
    const int tok = list[(size_t)ti.e * T + ti.row0 + r]; const float g = gate[tok * 4 + slot]; const float* bb = b2 + (size_t)ti.e * 1024 + c; float* o = h2 + (size_t)tok * D + c;
    o[0] += g * (v0 + bb[0]); o[1] += g * (v1 + bb[1]); o[2] += g * (v2 + bb[2]); o[3] += g * (v3 + bb[3]); } };

template <class TI>
__global__ __launch_bounds__(64) void k_kmean(const TI* __restrict__ k, long long ks, float* __restrict__ kmean) {
    const int n = blockIdx.x % NB, h = (blockIdx.x / NB) % HM, b = blockIdx.x / (NB * HM), d = threadIdx.x;
    float s = 0.f;
    for (int kk = 0; kk < 256; ++kk) s += ldf(k, ((size_t)b * S + n * 256 + kk) * ks + h * 64 + d);
    kmean[(size_t)blockIdx.x * 64 + d] = s * (1.0f / 256.0f);
}
template <class TI, class TO>
__global__ __launch_bounds__(64) void k_moba(const TI* __restrict__ qb, long long qs, const TI* __restrict__ kb, const TI* __restrict__ vb, long long ks, float qscale, float vpre, const float* __restrict__ kmean, TO* __restrict__ mix) {
    const int qc = blockIdx.x % (S / 64), h = (blockIdx.x / (S / 64)) % HM, b = blockIdx.x / ((S / 64) * HM);
    const int qpos = qc * 64 + threadIdx.x; const size_t t = (size_t)b * S + qpos;
    float q[64];
#pragma unroll
    for (int d = 0; d < 64; ++d) q[d] = ldf(qb, t * qs + h * 64 + d) * qscale;
    const int own = qpos >> 8;
    float g0 = -INFINITY, g1 = -INFINITY, g2 = -INFINITY; int i0 = -1, i1 = -1, i2 = -1;
    for (int n = 0; n < own; ++n) {
        const float* km = kmean + (((size_t)b * HM + h) * NB + n) * 64; float s = 0.f;
#pragma unroll
        for (int d = 0; d < 64; ++d) s += q[d] * km[d];
        if (s > g0) { g2 = g1; i2 = i1; g1 = g0; i1 = i0; g0 = s; i0 = n; }
        else if (s > g1) { g2 = g1; i2 = i1; g1 = s; i1 = n; }
        else if (s > g2) { g2 = s; i2 = n; }
    }
    const float slope = exp2f(-(float)(h + 1)); const float sl2 = slope * 1.4426950408889634f;
    float m = -INFINITY, l = 0.f; float o[64];
#pragma unroll
    for (int d = 0; d < 64; ++d) o[d] = 0.f;
    for (int j = 0; j < 4; ++j) {
        const int nblk = (j == 0) ? i0 : (j == 1) ? i1 : (j == 2) ? i2 : own;
        if (nblk < 0) continue;
        const int kend = (j < 3) ? 256 : (qpos - own * 256 + 1);
        for (int kk = 0; kk < kend; ++kk) {
            const int kpos = nblk * 256 + kk; const size_t ko = ((size_t)b * S + kpos) * ks + h * 64;
            float s = 0.f;
#pragma unroll
            for (int d = 0; d < 64; ++d) s += q[d] * ldf(kb, ko + d);
            s -= slope * (float)(qpos - kpos);
            const float mn = fmaxf(m, s), corr = expf(m - mn); float pe = expf(s - mn);
            l = l * corr + pe;
            if (vpre != 0.f) pe *= exp2f(-sl2 * (float)(kpos & 63));
#pragma unroll
            for (int d = 0; d < 64; ++d) o[d] = o[d] * corr + pe * ldf(vb, ko + d);
            m = mn;
        }
    }
    const float inv = 1.0f / l;
#pragma unroll
    for (int d = 0; d < 64; ++d) stf(mix, t * D + h * 64 + d, o[d] * inv);
}

__global__ __launch_bounds__(256) void k_gla_gate(const float* __restrict__ proj, const float* __restrict__ wg, const float* __restrict__ bg, float* __restrict__ la) {
    const size_t t = blockIdx.x; const int j = threadIdx.x;
    float z = bg[j];
#pragma unroll
    for (int r = 0; r < 16; ++r) z += proj[t * PW + C_AG + r] * wg[r * 256 + j];
    const float ls = fminf(z, 0.f) - log1pf(expf(-fabsf(z)));
    la[t * 256 + j] = ls * (1.0f / 16.0f);
}
template <class TI>
__global__ __launch_bounds__(128) void k_gla_rec(const TI* __restrict__ qb, const TI* __restrict__ kb, long long qs, const TI* __restrict__ vb, long long vs, const float* __restrict__ la, float* __restrict__ ogla) {
    const int b = blockIdx.x / HG, h = blockIdx.x % HG, dv = threadIdx.x;
    float s[64];
#pragma unroll
    for (int i = 0; i < 64; ++i) s[i] = 0.f;
    for (int t = 0; t < S; ++t) {
        const size_t row = (size_t)b * S + t; const float* ap = la + row * 256 + h * 64;
        const float v = ldf(vb, row * vs + h * 128 + dv); float o = 0.f;
#pragma unroll
        for (int i = 0; i < 64; ++i) { s[i] = expf(ap[i]) * s[i] + ldf(kb, row * qs + h * 64 + i) * v; o += ldf(qb, row * qs + h * 64 + i) * s[i]; }
        ogla[row * 512 + h * 128 + dv] = o * 0.125f;
    }
}
template <class TI, class TO>
__global__ __launch_bounds__(256) void k_gla_post(const float* __restrict__ ogla, const float* __restrict__ g, const TI* __restrict__ rg, long long rs, float rg_silu, TO* __restrict__ mix) {
    const int row = blockIdx.x * 4 + (threadIdx.x >> 6), lane = threadIdx.x & 63;
    const size_t t = row >> 2; const int h = row & 3;
    const float* xr = ogla + (size_t)row * 128; const float a = xr[lane], b = xr[lane + 64]; float s = a * a + b * b;
    for (int o = 32; o >= 1; o >>= 1) s += __shfl_xor(s, o);
    const float r = 1.0f / sqrtf(s / 128.0f + EPS);
    float r0 = ldf(rg, t * rs + h * 128 + lane), r1 = ldf(rg, t * rs + h * 128 + lane + 64);
    if (rg_silu == 0.f) { r0 = r0 * sigm(r0); r1 = r1 * sigm(r1); }
    stf(mix, t * D + 512 + h * 128 + lane, a * r * g[lane] * r0);
    stf(mix, t * D + 512 + h * 128 + lane + 64, b * r * g[lane + 64] * r1);
}

__global__ __launch_bounds__(256) void k_cvt_bf16_f32(const bf16_t* __restrict__ a, float* __restrict__ o, long long n) { for (long long i = (long long)blockIdx.x * 256 + threadIdx.x; i < n; i += (long long)gridDim.x * 256) o[i] = bf2f(a[i]); }
__global__ __launch_bounds__(256) void k_topk(const float* __restrict__ logits, int* __restrict__ tope, float* __restrict__ gate) {
    const int t = blockIdx.x * 256 + threadIdx.x; if (t >= T) return;
    float v[32];
#pragma unroll
    for (int e = 0; e < 32; ++e) v[e] = logits[(size_t)t * 32 + e];
    float tv[4]; int te[4]; unsigned used = 0u;
#pragma unroll
    for (int j = 0; j < 4; ++j) { float best = -INFINITY; int bi = 0;
#pragma unroll
        for (int e = 0; e < 32; ++e) { const bool ok = !((used >> e) & 1u) && v[e] > best; best = ok ? v[e] : best; bi = ok ? e : bi; }
        used |= 1u << bi; tv[j] = best; te[j] = bi; }
    const float e0 = 1.0f, e1 = expf(tv[1] - tv[0]), e2 = expf(tv[2] - tv[0]), e3 = expf(tv[3] - tv[0]); const float inv = 1.0f / (e0 + e1 + e2 + e3);
    tope[t * 4 + 0] = te[0]; tope[t * 4 + 1] = te[1]; tope[t * 4 + 2] = te[2]; tope[t * 4 + 3] = te[3];
    gate[t * 4 + 0] = e0 * inv; gate[t * 4 + 1] = e1 * inv; gate[t * 4 + 2] = e2 * inv; gate[t * 4 + 3] = e3 * inv;
}
__global__ __launch_bounds__(64) void k_sort_slot(const int* __restrict__ tope, long long slot_, int* __restrict__ list, int* __restrict__ cnt) {
    const int slot = (int)slot_;
    const int e = blockIdx.x, lane = threadIdx.x; int base = 0;
    for (int t0 = 0; t0 < T; t0 += 64) { const int t = t0 + lane; const bool hit = tope[t * 4 + slot] == e; const unsigned long long m = __ballot(hit);
        const int pos = base + __popcll(m & ((1ull << lane) - 1ull)); if (hit) list[(size_t)e * T + pos] = t; base += __popcll(m); }
    if (lane == 0) cnt[e] = base;
}
}

namespace pg8 {
#define PG8_LAS __attribute__((address_space(3)))
typedef short bf16x8 __attribute__((ext_vector_type(8)));
typedef float f32x4 __attribute__((ext_vector_type(4)));
typedef unsigned u32x4 __attribute__((ext_vector_type(4)));
typedef unsigned u32x2 __attribute__((ext_vector_type(2)));
constexpr int BM = 256, BK = 64, HALF = 128, HTB = HALF * BK * 2  , STAGE_BYTES = 8 * HTB, NXCD = 8, WGM = 8;

__host__ __device__ __forceinline__ int lds_byte(int r, int c) { const int st = (r >> 4) * 2 + (c >> 5), rr = r & 15, cc = c & 31, ob = rr * 64 + cc * 2; return st * 1024 + (ob ^ (((ob >> 9) & 1) << 5)); }
__host__ __device__ __forceinline__ void stage_rc(int b, int& R, int& C) { const int st = b / 1024, sb = b % 1024, swz = sb ^ (((sb >> 9) & 1) << 5); R = (st >> 1) * 16 + swz / 64; C = (st & 1) * 32 + (swz % 64) / 2; }
__host__ __device__ __forceinline__ int perm32(int rho) { const int n = rho >> 4, i = rho & 15; return 8 * (i >> 2) + 4 * n + (i & 3); }

struct Unit { int pm, pn, e, nrows, ml; };

struct StaticOrder {
    int nM, nN, nwg, G, c;
    __host__ __device__ __forceinline__ void init(int M, int N, int G_, int c_) { nM = M / BM; nN = N / BM; nwg = nM * nN; G = G_; c = c_; }
    __host__ __device__ __forceinline__ bool next(int i, Unit& u) const { return at((long)i * G + c, u); }
    __host__ __device__ __forceinline__ bool at(const long L, Unit& u) const {
        if (L >= nwg) return false;
        int wgid = (int)L; { const int q = nwg / NXCD, r = nwg % NXCD, xcd = wgid % NXCD, off = wgid / NXCD; wgid = (xcd < r ? xcd * (q + 1) : r * (q + 1) + (xcd - r) * q) + off; }
        const int nig = WGM * nN, gid = wgid / nig, fm = gid * WGM, gsz = (nM - fm) < WGM ? (nM - fm) : WGM;
        u.pm = fm + ((wgid % nig) % gsz); u.pn = (wgid % nig) / gsz; u.e = 0; u.nrows = 256; u.ml = 0; return true;
    }
};

typedef int v8i __attribute__((ext_vector_type(8)));
typedef int v4i __attribute__((ext_vector_type(4)));
__device__ __forceinline__ v8i cat8i(const bf16x8 a, const bf16x8 b) { const v4i x = __builtin_bit_cast(v4i, a), y = __builtin_bit_cast(v4i, b); return __builtin_shufflevector(x, y, 0, 1, 2, 3, 4, 5, 6, 7); }
__device__ __forceinline__ unsigned pk4_fp8(float a, float b, float c, float d) { int w = 0; w = __builtin_amdgcn_cvt_pk_fp8_f32(a, b, w, false); w = __builtin_amdgcn_cvt_pk_fp8_f32(c, d, w, true); return (unsigned)w; }
__device__ __forceinline__ unsigned cvt_pk_bf16(float lo, float hi) { unsigned r; asm volatile("v_cvt_pk_bf16_f32 %0, %1, %2" : "=v"(r) : "v"(lo), "v"(hi)); return r; }
__device__ __forceinline__ u32x4 pack8(const f32x4 v0, const f32x4 v1) { u32x4 w; w.x = cvt_pk_bf16(v0[0], v0[1]); w.y = cvt_pk_bf16(v0[2], v0[3]); w.z = cvt_pk_bf16(v1[0], v1[1]); w.w = cvt_pk_bf16(v1[2], v1[3]); return w; }

template <class E> __device__ __forceinline__ void st_rows16(E* p, const size_t ld8, const u32x4 w0, const u32x4 w1, const bool high) {
    u32x4 d1, d2;
#pragma unroll
    for (int q = 0; q < 4; ++q) { const unsigned x = high ? w0[q] : w1[q]; const unsigned y = (unsigned)__builtin_amdgcn_update_dpp(0, (int)x, 0x128, 0xf, 0xf, true); d1[q] = high ? y : w0[q]; d2[q] = high ? w1[q] : y; }
    *(u32x4*)p = d1; *(u32x4*)(p + ld8) = d2;
}
template <class P, bool ALIGN_EPI = true, bool SP2 = true>
__device__ __forceinline__ void gemm_phase(PG8_LAS unsigned char* lds, const P& pr, const int wid  ) {
    const int lane = mk_lane_id(), tid = wid * 64 + lane, wr = wid >> 2, wc = wid & 3, fr = lane & 15, fq = lane >> 4;
    constexpr int K = P::K, nt = K / BK;
    unsigned voffB[2];
#pragma unroll
    for (int i = 0; i < 2; ++i) { int R, C; stage_rc(tid * 16 + i * 8192, R, C); const int Rb = P::PERM64 ? ((R >> 5) * 64 + 2 * perm32(R & 31) - (perm32(R & 31) & 7)) : P::PERM ? ((R & ~31) + perm32(R & 31)) : R; voffB[i] = (unsigned)(Rb * K + C) * 2u; }
    const size_t kstep = (size_t)(BK * 2);
    const size_t hstep = (size_t)(P::PERM64 ? 8 : HALF) * K * 2;
    const unsigned ldsw = (unsigned)wid * 1024u;
    const int aoff = lds_byte(wr * 64 + fr, fq * 8), boff = lds_byte(wc * 32 + fr, fq * 8);
#define PG8_SA(b, h) (((b) * 2 + (h)) * HTB)
#define PG8_SB(b, h) ((4 + (b) * 2 + (h)) * HTB)
#define PG8_STAGE(bufoff, gbase, voff) do { _Pragma("unroll") for (int _i = 0; _i < 2; ++_i) \
        __builtin_amdgcn_global_load_lds((const unsigned*)((const char*)(gbase) + (voff)[_i]), (PG8_LAS unsigned*)(lds + (bufoff) + ldsw + _i * 8192), 16, 0, 0); } while (0)
#define PG8_LDA(dst, b, h) do { if constexpr (P::F8) { _Pragma("unroll") for (int m = 0; m < 4; ++m) dst##8[m] = cat8i(*(const PG8_LAS bf16x8*)(lds + PG8_SA(b, h) + aoff + m * 2048), *(const PG8_LAS bf16x8*)(lds + PG8_SA(b, h) + aoff + m * 2048 + 1024)); } \
        else { _Pragma("unroll") for (int m = 0; m < 4; ++m) _Pragma("unroll") for (int k = 0; k < 2; ++k) dst[m][k] = *(const PG8_LAS bf16x8*)(lds + PG8_SA(b, h) + aoff + m * 2048 + k * 1024); } } while (0)
#define PG8_LDB(dst, b, h) do { if constexpr (P::F8) { _Pragma("unroll") for (int n = 0; n < 2; ++n) dst##8[n] = cat8i(*(const PG8_LAS bf16x8*)(lds + PG8_SB(b, h) + boff + n * 2048), *(const PG8_LAS bf16x8*)(lds + PG8_SB(b, h) + boff + n * 2048 + 1024)); } \
        else { _Pragma("unroll") for (int n = 0; n < 2; ++n) _Pragma("unroll") for (int k = 0; k < 2; ++k) dst[n][k] = *(const PG8_LAS bf16x8*)(lds + PG8_SB(b, h) + boff + n * 2048 + k * 1024); } } while (0)
#define PG8_MMA(ai, bj, At, Bt) do { __builtin_amdgcn_s_setprio(1); \
        if constexpr (P::F8) { _Pragma("unroll") for (int m = 0; m < 4; ++m) _Pragma("unroll") for (int n = 0; n < 2; ++n) \
            acc[ai][bj][m][n] = __builtin_amdgcn_mfma_scale_f32_16x16x128_f8f6f4(Bt##8[n], At##8[m], acc[ai][bj][m][n], 0, 0, 0, P::SCALE_B, 0, P::SCALE_A); } \
        else { _Pragma("unroll") for (int m = 0; m < 4; ++m) _Pragma("unroll") for (int n = 0; n < 2; ++n) _Pragma("unroll") for (int k = 0; k < 2; ++k) \
            acc[ai][bj][m][n] = __builtin_amdgcn_mfma_f32_16x16x32_bf16(Bt[n][k], At[m][k], acc[ai][bj][m][n], 0, 0, 0); } \
        __builtin_amdgcn_s_setprio(0); } while (0)
#define PG8_WAIT_V(n) asm volatile("s_waitcnt vmcnt(" #n ")" ::: "memory")
#define PG8_WAIT_L(n) asm volatile("s_waitcnt lgkmcnt(" #n ")" ::: "memory")
#define PG8_BAR __builtin_amdgcn_s_barrier()
#define PG8_SCHED __builtin_amdgcn_sched_barrier(0)
    Unit cur, nxt; int ui = 0;
    if (!pr.next(0, cur)) return;
    f32x4 acc[2][2][4][2];
#pragma unroll
    for (int a = 0; a < 2; ++a)
#pragma unroll
        for (int b = 0; b < 2; ++b)
#pragma unroll
            for (int m = 0; m < 4; ++m)
#pragma unroll
                for (int n = 0; n < 2; ++n) acc[a][b][m][n] = (f32x4){0.f, 0.f, 0.f, 0.f};
    bf16x8 At[4][2], B0[2][2], B1[2][2]; v8i At8[4], B08[2], B18[2];
    unsigned oAc[2][2];
    PG8_LAS u32x4* const oslot = (PG8_LAS u32x4*)(lds + STAGE_BYTES + 2048) + tid;
    pr.a_offs(cur, tid, oAc);
    const char* cA = pr.a_base(cur); const char* cB = pr.b_base(cur);
    PG8_STAGE(PG8_SB(0, 0), cB, voffB); PG8_STAGE(PG8_SB(0, 1), cB + hstep, voffB); PG8_STAGE(PG8_SA(0, 0), cA, oAc[0]); PG8_STAGE(PG8_SA(0, 1), cA, oAc[1]);
    if (wr == 1) PG8_BAR;
    PG8_WAIT_V(2); PG8_BAR;
    PG8_STAGE(PG8_SB(1, 0), cB + kstep, voffB); PG8_STAGE(PG8_SA(1, 0), cA + kstep, oAc[0]); PG8_STAGE(PG8_SB(1, 1), cB + hstep + kstep, voffB);
    PG8_WAIT_V(6); PG8_BAR;
    for (;;) {
        const bool has_next = pr.next(ui + 1, nxt);
        const char* nA = cA; const char* nB = cB;
        if (has_next) { nA = pr.a_base(nxt); nB = pr.b_base(nxt);
            if constexpr (P::LIST_DMA) pr.a_offs_dma(nxt, lds, wid, lane);
            else if constexpr (P::GATHER) { unsigned on[2][2]; pr.a_offs(nxt, tid, on); *oslot = (u32x4){on[0][0], on[0][1], on[1][0], on[1][1]}; } }
#pragma unroll 1
        for (int t = 0; t < nt; t += 2) {
            const bool last = (t == nt - 2);
            const char* a1 = cA + (size_t)(t + 1) * kstep;
            const char* a2 = last ? nA : cA + (size_t)(t + 2) * kstep; const char* b2 = last ? nB : cB + (size_t)(t + 2) * kstep;
            const char* a3 = a2 + kstep; const char* b3 = b2 + kstep;
            if constexpr (P::EPI_DMA) { if (last) pr.epi_dma(cur, lds, wid, lane); }
            PG8_LDB(B0, 0, 0); PG8_LDB(B1, 0, 1); PG8_SCHED; PG8_LDA(At, 0, 0); PG8_STAGE(PG8_SA(1, 1), a1, oAc[1]);
            if constexpr (P::LIST_DMA) { if (last && has_next) pr.a_offs_ld(lds, wid, lane, oAc); }
            else if constexpr (P::GATHER) { if (last && has_next) {
                const u32x4 on = *oslot; oAc[0][0] = on[0]; oAc[0][1] = on[1]; oAc[1][0] = on[2]; oAc[1][1] = on[3]; } }
            PG8_WAIT_V(8); PG8_WAIT_L(0); PG8_BAR; PG8_MMA(0, 0, At, B0); PG8_MMA(0, 1, At, B1); PG8_BAR; PG8_SCHED;
            PG8_LDA(At, 0, 1); PG8_STAGE(PG8_SB(0, 0), b2, voffB); PG8_STAGE(PG8_SB(0, 1), b2 + hstep, voffB); PG8_STAGE(PG8_SA(0, 0), a2, oAc[0]);
            PG8_WAIT_V(8); PG8_WAIT_L(0); PG8_BAR; PG8_MMA(1, 0, At, B0); PG8_MMA(1, 1, At, B1); PG8_BAR; PG8_SCHED;
            PG8_LDB(B0, 1, 0); PG8_LDB(B1, 1, 1); PG8_SCHED; PG8_LDA(At, 1, 0); PG8_STAGE(PG8_SA(0, 1), a2, oAc[1]);
            PG8_WAIT_V(8); PG8_WAIT_L(0); PG8_BAR; PG8_MMA(0, 0, At, B0); PG8_MMA(0, 1, At, B1); PG8_BAR; PG8_SCHED;
            PG8_LDA(At, 1, 1); PG8_STAGE(PG8_SB(1, 0), b3, voffB); PG8_STAGE(PG8_SB(1, 1), b3 + hstep, voffB); PG8_STAGE(PG8_SA(1, 0), a3, oAc[0]);
            PG8_WAIT_V(8); PG8_WAIT_L(0); PG8_BAR; PG8_MMA(1, 0, At, B0); PG8_MMA(1, 1, At, B1); PG8_BAR; PG8_SCHED;
        }
        if constexpr (ALIGN_EPI) { if (wr == 0) PG8_BAR; }
        { int fr_ = fr, fq_ = fq; asm volatile("" : "+v"(fr_), "+v"(fq_));
          pr.epilogue(acc, cur, wr, wc, fr_, fq_); }
        if (!has_next) break;
#pragma unroll
        for (int a = 0; a < 2; ++a)
#pragma unroll
            for (int b = 0; b < 2; ++b)
#pragma unroll
                for (int m = 0; m < 4; ++m)
#pragma unroll
                    for (int n = 0; n < 2; ++n) acc[a][b][m][n] = (f32x4){0.f, 0.f, 0.f, 0.f};
        cur = nxt; cA = nA; cB = nB; ++ui;
        if constexpr (ALIGN_EPI) { if (wr == 1) PG8_BAR; }
    }
    PG8_WAIT_V(0);
    if constexpr (!ALIGN_EPI) { if (wr == 0) PG8_BAR; }
    PG8_BAR;
#undef PG8_SA
#undef PG8_SB
#undef PG8_STAGE
#undef PG8_LDA
#undef PG8_LDB
#undef PG8_MMA
#undef PG8_WAIT_V
#undef PG8_WAIT_L
#undef PG8_BAR
#undef PG8_SCHED
}
}
#include <hip/hip_bf16.h>
#include <cmath>
namespace attn_body {
using bf16=__hip_bfloat16;
using bf16x8=__attribute__((ext_vector_type(8)))short;
using s16x4=__attribute__((ext_vector_type(4)))short;
using f32x16=__attribute__((ext_vector_type(16)))float;
using u32x4=__attribute__((ext_vector_type(4)))unsigned;
constexpr int BATCH=8,NHEAD=8,SEQ=4096,D=64,DM=NHEAD*D,OPITCH=1024;
constexpr int NW=8,QBLK=32,QB=QBLK*NW,KVBLK=64,NQB=SEQ/QB;
constexpr int ATTN_PITCH=DM, ATTN_UNIT_ROWS=QB;
__device__ __forceinline__ int crow(int r,int hi){return (r&3)+8*(r>>2)+4*hi;}
#define SBAR() __builtin_amdgcn_sched_barrier(0)
__device__ __forceinline__ void cmask(f32x16&p0,f32x16&p1,int jb,int qrel,int hi){
  const float NEG=-INFINITY; int kb=64*jb+4*hi;
  #pragma unroll
  for(int r=0;r<16;++r){int kv=kb+(r&3)+8*(r>>2); if(kv>qrel)p0[r]=NEG; if(kv+32>qrel)p1[r]=NEG;}
}

constexpr int NSLOT=3, SLOTB=8192;
constexpr int LDS_K=0, LDS_V=NSLOT*SLOTB, LDS_WS=2*NSLOT*SLOTB, LDS_OST=LDS_WS+NW*64*4, LDS_BYTES=LDS_OST+NW*4096;
constexpr float C2=0.125f*1.4426950408889634f;
__device__ __forceinline__ void glds16(const void*gsrc,unsigned lds_dst){unsigned keep;
  asm volatile("s_mov_b32 %0, m0\n\ts_mov_b32 m0, %2\n\ts_nop 0\n\tglobal_load_lds_dwordx4 %1, off\n\ts_mov_b32 m0, %0":"=&s"(keep):"v"(gsrc),"s"(lds_dst):"memory");}
__device__ __forceinline__ float max3f(float a,float b,float c){float r;asm("v_max3_f32 %0, %1, %2, %3":"=v"(r):"v"(a),"v"(b),"v"(c));return r;}
__device__ __forceinline__ float max2f(float a,float b){float r;asm("v_max_f32_e32 %0, %1, %2":"=v"(r):"v"(a),"v"(b));return r;}
__device__ __forceinline__ float fadd_s(float a,float b){float r;asm("v_add_f32_e32 %0, %1, %2":"=v"(r):"v"(a),"v"(b));return r;}
__device__ __forceinline__ float fsub_s(float a,float b){float r;asm("v_sub_f32_e32 %0, %1, %2":"=v"(r):"v"(a),"v"(b));return r;}
typedef float f32x2_t __attribute__((ext_vector_type(2))); typedef __bf16 bf16x2_t __attribute__((ext_vector_type(2)));
__device__ __forceinline__ unsigned cvtpk_s(float lo,float hi){f32x2_t v={lo,hi};bf16x2_t b=__builtin_convertvector(v,bf16x2_t);return __builtin_bit_cast(unsigned,b);}
#define WAIT_BAR(N) asm volatile("s_waitcnt vmcnt(" #N ") lgkmcnt(0)\n\ts_barrier":::"memory")

__device__ __forceinline__ void qkt(f32x16&p0,f32x16&p1,const char*Kslot,const bf16x8*qr,const f32x16&negm,int r32,int hi){
  const char*kb=Kslot+hi*1024+r32*16;
  #pragma unroll
  for(int d0=0;d0<4;++d0){
    const bf16x8 b0=*reinterpret_cast<const bf16x8*>(kb+d0*2048);
    const bf16x8 b1=*reinterpret_cast<const bf16x8*>(kb+d0*2048+512);
    if(d0==0){p0=__builtin_amdgcn_mfma_f32_32x32x16_bf16(b0,qr[0],negm,0,0,0);p1=__builtin_amdgcn_mfma_f32_32x32x16_bf16(b1,qr[0],negm,0,0,0);}
    else{p0=__builtin_amdgcn_mfma_f32_32x32x16_bf16(b0,qr[d0],p0,0,0,0);p1=__builtin_amdgcn_mfma_f32_32x32x16_bf16(b1,qr[d0],p1,0,0,0);}}
}
typedef __attribute__((address_space(3))) const char* lds_cptr;
typedef short v4i16_t __attribute__((ext_vector_type(4)));
__device__ __forceinline__ void kload8(bf16x8*kf,lds_cptr kp){
  kf[0]=*(const __attribute__((address_space(3))) bf16x8*)(kp);      kf[1]=*(const __attribute__((address_space(3))) bf16x8*)(kp+512);
  kf[2]=*(const __attribute__((address_space(3))) bf16x8*)(kp+2048); kf[3]=*(const __attribute__((address_space(3))) bf16x8*)(kp+2560);
  kf[4]=*(const __attribute__((address_space(3))) bf16x8*)(kp+4096); kf[5]=*(const __attribute__((address_space(3))) bf16x8*)(kp+4608);
  kf[6]=*(const __attribute__((address_space(3))) bf16x8*)(kp+6144); kf[7]=*(const __attribute__((address_space(3))) bf16x8*)(kp+6656);
}
__device__ __forceinline__ void kload2(bf16x8*kf,lds_cptr kp,int j){ kf[2*j]=*(const __attribute__((address_space(3))) bf16x8*)(kp+j*2048); kf[2*j+1]=*(const __attribute__((address_space(3))) bf16x8*)(kp+j*2048+512); }
__device__ __forceinline__ s16x4 vtr(lds_cptr p){ return __builtin_bit_cast(s16x4,__builtin_amdgcn_ds_read_tr16_b64_v4i16((__attribute__((address_space(3))) v4i16_t*)p)); }
__device__ __forceinline__ float rowmax(const f32x16&p0,const f32x16&p1){
  float a=max3f(p0[0],p0[1],p1[0]),b=max3f(p0[2],p0[3],p1[1]);a=max3f(a,p1[2],p1[3]);
  #pragma unroll
  for(int r=4;r<16;r+=4){a=max3f(a,p0[r],p0[r+1]);b=max3f(b,p0[r+2],p0[r+3]);a=max3f(a,p1[r],p1[r+1]);b=max3f(b,p1[r+2],p1[r+3]);}
  const float m=max2f(a,b);
  auto rr=__builtin_amdgcn_permlane32_swap(__float_as_uint(m),__float_as_uint(m),false,false);
  return max2f(__uint_as_float(rr[0]),__uint_as_float(rr[1]));
}
__device__ __forceinline__ void pv(f32x16*o,int vb,bf16x8 pa0,bf16x8 pa1,bf16x8 pa2,bf16x8 pa3){
  #pragma unroll
  for(int d0=0;d0<2;++d0){s16x4 lo[4],hi[4];
    #pragma unroll
    for(int ks=0;ks<4;++ks){
      asm volatile("ds_read_b64_tr_b16 %0,%1 offset:%c2":"=&v"(lo[ks]):"v"(vb),"i"(d0*4096+ks*1024):"memory");
      asm volatile("ds_read_b64_tr_b16 %0,%1 offset:%c2":"=&v"(hi[ks]):"v"(vb),"i"(d0*4096+ks*1024+512):"memory");}
    asm volatile("s_waitcnt lgkmcnt(0)":::"memory");SBAR();
    #define PK(k) (bf16x8){lo[k][0],lo[k][1],lo[k][2],lo[k][3],hi[k][0],hi[k][1],hi[k][2],hi[k][3]}
    o[d0]=__builtin_amdgcn_mfma_f32_32x32x16_bf16(pa0,PK(0),o[d0],0,0,0);
    o[d0]=__builtin_amdgcn_mfma_f32_32x32x16_bf16(pa1,PK(1),o[d0],0,0,0);
    o[d0]=__builtin_amdgcn_mfma_f32_32x32x16_bf16(pa2,PK(2),o[d0],0,0,0);
    o[d0]=__builtin_amdgcn_mfma_f32_32x32x16_bf16(pa3,PK(3),o[d0],0,0,0);
    #undef PK
  }
}

#ifndef ATTN_STORE16
#define ATTN_STORE16(p,v) (*(u32x4*)(p)=(v))
#endif
template<int THRL> __device__ __forceinline__ void attn_unit(int b,int h,int qb,const bf16*Q,const bf16*__restrict__ K,const bf16*__restrict__ V,bf16*O,const float*__restrict__ KMEAN,char*shm,const int wid){
  const int lane=mk_lane_id(),r32=lane&31,hi=lane>>5;
  const long rowbase=(long)b*SEQ; const int q0=qb*QB;
  const bf16*Qw=Q+(rowbase+q0+wid*QBLK)*DM+h*D;
  const bf16*Kh=K+rowbase*DM+h*D,*Vh=V+rowbase*DM+h*D;
  const unsigned lds0=(unsigned)(uintptr_t)shm;
  float*wsf=(float*)(shm+LDS_WS)+wid*64;
  const bf16*ksrc=Kh+(long)lane*DM+wid*8;
  const bf16*vsrc=Vh+(long)(16*(wid&3)+(lane>>2))*DM+(wid>>2)*32+(lane&3)*8;
  const unsigned kdst=lds0+LDS_K+wid*1024, vdst=lds0+LDS_V+wid*1024;
  #define DMA_K(t,slot) glds16(ksrc+(long)(t)*KVBLK*DM,(unsigned)__builtin_amdgcn_readfirstlane(kdst+(slot)))
  #define DMA_V(t,slot) glds16(vsrc+(long)(t)*KVBLK*DM,(unsigned)__builtin_amdgcn_readfirstlane(vdst+(slot)))
  const int vb0=(int)(lds0+LDS_V)+((lane>>4)&1)*32+(lane&3)*8+(4*hi+((lane&15)>>2))*64;
  const char*Kbase=shm+LDS_K; bf16x8 kf[8];
  const lds_cptr shm3=(lds_cptr)shm; const lds_cptr kp0=shm3+LDS_K+hi*1024+r32*16; const lds_cptr vp0=shm3+LDS_V+((lane>>4)&1)*32+(lane&3)*8+(4*hi+((lane&15)>>2))*64;
  const int NT=(q0+QB)/KVBLK;
  DMA_K(0,0);DMA_V(0,0);DMA_K(1,SLOTB);
  bf16x8 qr[4];
  #pragma unroll
  for(int d0=0;d0<4;++d0)qr[d0]=*reinterpret_cast<const bf16x8*>(&Qw[(long)r32*DM+d0*16+hi*8]);
  if(qb>0){ const float*kmg=KMEAN+(((long)b*NHEAD+h)*NQB)*64; __attribute__((address_space(3))) char*kml=(__attribute__((address_space(3))) char*)((lds_cptr)shm+86016+wid*4096);
      typedef float f4v __attribute__((ext_vector_type(4))); f4v kv[4];
      #pragma unroll
      for(int r=0;r<4;++r){const int ch=r*64+lane; kv[r]=(ch<qb*16)?*reinterpret_cast<const f4v*>(kmg+ch*4):(f4v){0.f,0.f,0.f,0.f};}
      #pragma unroll
      for(int r=0;r<4;++r)*(__attribute__((address_space(3))) f4v*)(kml+(r*64+lane)*16)=kv[r];
      asm volatile("s_waitcnt lgkmcnt(0)":::"memory"); }
  #define USGPR(x) __uint_as_float((unsigned)__builtin_amdgcn_readfirstlane((int)__float_as_uint(x)))
  const float sl2=USGPR(__builtin_amdgcn_exp2f(-(float)(h+1))*1.4426950408889634f);
  const float sl2_64=USGPR(sl2*64.f);
  unsigned qmask=0u;
  if(qb>0){
    float qf[4][8];
    #pragma unroll
    for(int d0=0;d0<4;++d0){
      #pragma unroll
      for(int j=0;j<8;++j)qf[d0][j]=__uint_as_float(((unsigned)(unsigned short)qr[d0][j])<<16);}
    const __attribute__((address_space(3))) float*km=(const __attribute__((address_space(3))) float*)((lds_cptr)shm+86016+wid*4096)+8*hi;
    float g0=-INFINITY,g1=-INFINITY,g2=-INFINITY;int i0=-1,i1=-1,i2=-1;
    #pragma unroll 1
    for(int n=0;n<qb;++n){
      float s=0.f;
      #pragma unroll
      for(int d0=0;d0<4;++d0){
        typedef float f4w __attribute__((ext_vector_type(4))); const f4w a=*reinterpret_cast<const __attribute__((address_space(3))) f4w*>(km+n*64+16*d0),c=*reinterpret_cast<const __attribute__((address_space(3))) f4w*>(km+n*64+16*d0+4);
        s+=qf[d0][0]*a.x;s+=qf[d0][1]*a.y;s+=qf[d0][2]*a.z;s+=qf[d0][3]*a.w;s+=qf[d0][4]*c.x;s+=qf[d0][5]*c.y;s+=qf[d0][6]*c.z;s+=qf[d0][7]*c.w;}
      {auto rr=__builtin_amdgcn_permlane32_swap(__float_as_uint(s),__float_as_uint(s),false,false);s=__uint_as_float(rr[0])+__uint_as_float(rr[1]);}
      if(s>g0){g2=g1;i2=i1;g1=g0;i1=i0;g0=s;i0=n;}
      else if(s>g1){g2=g1;i2=i1;g1=s;i1=n;}
      else if(s>g2){g2=s;i2=n;}
    }
    qmask=(i0>=0?(1u<<i0):0u)|(i1>=0?(1u<<i1):0u)|(i2>=0?(1u<<i2):0u);
  }
  const __attribute__((address_space(3))) unsigned* qmp=(const __attribute__((address_space(3))) unsigned*)((lds_cptr)shm+LDS_WS+wid*256+r32*4+(83968-LDS_WS));
  *(__attribute__((address_space(3))) unsigned*)qmp=qmask;
  const float uA=USGPR(__builtin_amdgcn_exp2f(sl2)),uB1=USGPR(__builtin_amdgcn_exp2f(sl2*8.f));
  #define INNER(X,j) __builtin_fmaf(__builtin_fmaf(__builtin_fmaf(X[4*(j)+3],uA,X[4*(j)+2]),uA,X[4*(j)+1]),uA,X[4*(j)])
  asm volatile("s_waitcnt lgkmcnt(0)":::"memory");
  const lds_cptr qfp=(lds_cptr)shm+86016+wid*4096+lane*16;
  #pragma unroll
  for(int d0=0;d0<4;++d0)*(__attribute__((address_space(3))) bf16x8*)((__attribute__((address_space(3))) char*)qfp+d0*1024)=qr[d0];
  asm volatile("s_waitcnt lgkmcnt(0)":::"memory");
  #define QF(d0) (*(const __attribute__((address_space(3))) bf16x8*)(qfp+(d0)*1024))
  float mhat=0.f,l_reg=0.f;f32x16 o[2];o[0]=f32x16{};o[1]=f32x16{};f32x16 negm=f32x16{};asm volatile("":"+v"(negm));
  const int qrel=wid*QBLK+r32;
  #define TBIAS(t) ((((t)>=NT-4)||(((*qmp)>>((t)>>2))&1u))?sl2_64*(float)((t)-(NT-4)):-INFINITY)
  #define TBIASQ(t,QM) ((((t)>=NT-4)||(((QM)>>((t)>>2))&1u))?sl2_64*(float)((t)-(NT-4)):-INFINITY)
  #define CINITQ(t,QM) do{const float c_=TBIASQ(t,QM)-mhat; _Pragma("unroll") for(int r=0;r<16;++r)negm[r]=c_; asm volatile("":"+v"(negm));}while(0)
  #define CINIT(t) do{const float c_=TBIAS(t)-mhat; _Pragma("unroll") for(int r=0;r<16;++r)negm[r]=c_; asm volatile("":"+v"(negm));}while(0)
  #define CMASK(P0,P1,t) do{int jb_=(t)-(NT-4); if(jb_>=0)cmask(P0,P1,jb_,qrel,hi);}while(0)
  bool resc=false;
  #define START(P0,P1) do{ const float rm=rowmax(P0,P1); resc=false; \
    { const float dl=(rm==-INFINITY)?0.f:rm; mhat=fadd_s(mhat,dl); \
      _Pragma("unroll") for(int r=0;r<16;++r){P0[r]=fsub_s(P0[r],dl);P1[r]=fsub_s(P1[r],dl);} } \
    _Pragma("unroll") for(int r=0;r<16;++r)P0[r]=__builtin_amdgcn_exp2f(P0[r]); }while(0)
  #define RESC() do{ if(resc){ asm volatile("s_waitcnt lgkmcnt(0)":::"memory"); \
      _Pragma("unroll") for(int d_=0;d_<2;++d_) _Pragma("unroll") for(int r=0;r<16;++r)o[d_][r]*=wsf[crow(r,hi)]; } }while(0)
  f32x16 pA0,pA1,pB0,pB1;
  int sl_prev=0,sl_cur=0,sl_next=SLOTB;
  #define ROT() do{sl_prev=sl_cur;sl_cur=sl_next;sl_next=(sl_next==(NSLOT-1)*SLOTB)?0:sl_next+SLOTB;}while(0)
  DMA_K(2,2*SLOTB);
  WAIT_BAR(3);
  CINIT(0);
  qkt(pA0,pA1,Kbase,qr,negm,r32,hi);asm volatile("s_nop 15\n\ts_nop 7":"+v"(pA0),"+v"(pA1));CMASK(pA0,pA1,0);
  START(pA0,pA1);
  _Pragma("unroll") for(int r=0;r<16;++r)pA1[r]=__builtin_amdgcn_exp2f(pA1[r]);
  WAIT_BAR(0);
  DMA_K(3,0);DMA_V(1,SLOTB);
  ROT();
  kload8(kf,kp0+sl_cur);
  WAIT_BAR(2);
  s16x4 vlo[8],vhi[8]; u32x4 pw0,pw1,pw2,pw3;
  #define PKW(P,B) cvtpk_s(P[B],P[B+1])
  #define PAF(k) __builtin_bit_cast(bf16x8,pw##k)
  #define VFR(i) (bf16x8){vlo[i][0],vlo[i][1],vlo[i][2],vlo[i][3],vhi[i][0],vhi[i][1],vhi[i][2],vhi[i][3]}
  #define PIN(x) asm volatile("":"+v"(x))
  #define MX3(a,b,c) __builtin_fmaxf(__builtin_fmaxf((a),(b)),(c))
  #define GAPA(MF,F0,W0,W1,PW) do{ MF; F0; PIN(sacc); W0; W1; PIN(PW); SBAR(); }while(0)
  #define FNOP (void)0
  #define EX(v) __builtin_amdgcn_exp2f(v)
  #define GAPB(MF,X,B) do{ MF; X[B]=EX(X[B]); X[B+1]=EX(X[B+1]); X[B+2]=EX(X[B+2]); X[B+3]=EX(X[B+3]); PIN(X); SBAR(); }while(0)
  #define VRD(i) do{ vlo[i]=vtr(vp_+(((i)>>2)*4096+((i)&3)*1024)); vhi[i]=vtr(vp_+(((i)>>2)*4096+((i)&3)*1024+512)); }while(0)
  #define KRD(G,j) do{ if(G){ kload2(kf,kp0+sl_next,j); SBAR(); } }while(0)
  #define STEP(C0,C1,P0,P1,t,GK,GV,GL) do{ SBAR(); const bf16x8 q0_=QF(0),q1_=QF(1),q2_=QF(2),q3_=QF(3); CINIT(t); SBAR(); \
    const lds_cptr vp_=vp0+sl_prev; \
    VRD(0); SBAR(); float sacc; \
    GAPA(C0=__builtin_amdgcn_mfma_f32_32x32x16_bf16(kf[0],q0_,negm,0,0,0), sacc=INNER(P1,3),     pw0[0]=PKW(P0,0), pw0[1]=PKW(P0,2), pw0); \
    VRD(4); SBAR(); GAPA(C1=__builtin_amdgcn_mfma_f32_32x32x16_bf16(kf[1],q0_,negm,0,0,0), sacc=__builtin_fmaf(sacc,uB1,INNER(P1,2)),     pw0[2]=PKW(P0,4), pw0[3]=PKW(P0,6), pw0); \
    VRD(1); SBAR(); GAPA(C0=__builtin_amdgcn_mfma_f32_32x32x16_bf16(kf[2],q1_,C0,0,0,0),   sacc=__builtin_fmaf(sacc,uB1,INNER(P1,1)), pw1[0]=PKW(P0,8), pw1[1]=PKW(P0,10), pw1); \
    VRD(5); SBAR(); GAPA(C1=__builtin_amdgcn_mfma_f32_32x32x16_bf16(kf[3],q1_,C1,0,0,0),   sacc=__builtin_fmaf(sacc,uB1,INNER(P1,0)),   pw1[2]=PKW(P0,12),pw1[3]=PKW(P0,14), pw1); \
    VRD(2); SBAR(); GAPA(C0=__builtin_amdgcn_mfma_f32_32x32x16_bf16(kf[4],q2_,C0,0,0,0),   sacc=__builtin_fmaf(sacc,uB1,INNER(P0,3)),     pw2[0]=PKW(P1,0), pw2[1]=PKW(P1,2), pw2); \
    VRD(6); SBAR(); GAPA(C1=__builtin_amdgcn_mfma_f32_32x32x16_bf16(kf[5],q2_,C1,0,0,0),   sacc=__builtin_fmaf(sacc,uB1,INNER(P0,2)),     pw2[2]=PKW(P1,4), pw2[3]=PKW(P1,6), pw2); \
    VRD(3); SBAR(); GAPA(C0=__builtin_amdgcn_mfma_f32_32x32x16_bf16(kf[6],q3_,C0,0,0,0),   sacc=__builtin_fmaf(sacc,uB1,INNER(P0,1)), pw3[0]=PKW(P1,8), pw3[1]=PKW(P1,10), pw3); \
    VRD(7); SBAR(); GAPA(C1=__builtin_amdgcn_mfma_f32_32x32x16_bf16(kf[7],q3_,C1,0,0,0),   sacc=__builtin_fmaf(sacc,uB1,INNER(P0,0)),       pw3[2]=PKW(P1,12),pw3[3]=PKW(P1,14), pw3); \
    l_reg+=sacc; \
    if(GK){DMA_K((t)+3,sl_cur);} if(GV){DMA_V((t)+1,sl_next);} \
    CMASK(C0,C1,t); \
    { float a=MX3(C0[0],C0[1],C1[0]),b=MX3(C0[2],C0[3],C1[1]); a=MX3(a,C1[2],C1[3]); \
      _Pragma("unroll") for(int r=4;r<16;r+=4){a=MX3(a,C0[r],C0[r+1]);b=MX3(b,C0[r+2],C0[r+3]);a=MX3(a,C1[r],C1[r+1]);b=MX3(b,C1[r+2],C1[r+3]);} \
      float rm=__builtin_fmaxf(a,b); { auto rr=__builtin_amdgcn_permlane32_swap(__float_as_uint(rm),__float_as_uint(rm),false,false); rm=__builtin_fmaxf(__uint_as_float(rr[0]),__uint_as_float(rr[1])); } \
      resc=false; \
      if(__builtin_expect(__any(rm>(float)THRL),0)){ const float dl=__builtin_fmaxf(rm,0.f); mhat+=dl; \
        _Pragma("unroll") for(int r=0;r<16;++r){C0[r]-=dl;C1[r]-=dl;} \
        const float f=__builtin_amdgcn_exp2f(-dl); l_reg*=f; if(hi==0)wsf[r32]=f; resc=true; } } \
    SBAR(); \
    GAPB(o[0]=__builtin_amdgcn_mfma_f32_32x32x16_bf16(PAF(0),VFR(0),o[0],0,0,0), C0,0); \
    GAPB(o[1]=__builtin_amdgcn_mfma_f32_32x32x16_bf16(PAF(0),VFR(4),o[1],0,0,0), C0,4); \
    KRD(GL,0); GAPB(o[0]=__builtin_amdgcn_mfma_f32_32x32x16_bf16(PAF(1),VFR(1),o[0],0,0,0), C0,8); \
    KRD(GL,1); GAPB(o[1]=__builtin_amdgcn_mfma_f32_32x32x16_bf16(PAF(1),VFR(5),o[1],0,0,0), C0,12); \
    KRD(GL,2); GAPB(o[0]=__builtin_amdgcn_mfma_f32_32x32x16_bf16(PAF(2),VFR(2),o[0],0,0,0), C1,0); \
    KRD(GL,3); GAPB(o[1]=__builtin_amdgcn_mfma_f32_32x32x16_bf16(PAF(2),VFR(6),o[1],0,0,0), C1,4); \
    GAPB(o[0]=__builtin_amdgcn_mfma_f32_32x32x16_bf16(PAF(3),VFR(3),o[0],0,0,0), C1,8); \
    GAPB(o[1]=__builtin_amdgcn_mfma_f32_32x32x16_bf16(PAF(3),VFR(7),o[1],0,0,0), C1,12); \
    }while(0)
  int t=1;
  #undef CMASK
  #define CMASK(P0,P1,t) do{}while(0)
  for(;t+5<NT;t+=2){
    STEP(pB0,pB1,pA0,pA1,t,true,true,true);     WAIT_BAR(2); RESC(); ROT();
    STEP(pA0,pA1,pB0,pB1,t+1,true,true,true);   WAIT_BAR(2); RESC(); ROT();
  }
  #undef CMASK
  #define CMASK(P0,P1,t) do{int jb_=(t)-(NT-4); if(jb_>=0)cmask(P0,P1,jb_,qrel,hi);}while(0)
  #define ENDW(tt) do{ if((tt)+3<NT){WAIT_BAR(2);} else if((tt)+2<NT){WAIT_BAR(1);} else {WAIT_BAR(0);} }while(0)
  for(;t+1<NT;t+=2){
    STEP(pB0,pB1,pA0,pA1,t,(t+3<NT),(t+1<NT),(t+1<NT));       ENDW(t);   RESC(); ROT();
    STEP(pA0,pA1,pB0,pB1,t+1,(t+4<NT),(t+2<NT),(t+2<NT));     ENDW(t+1); RESC(); ROT();
  }
  STEP(pB0,pB1,pA0,pA1,NT-1,false,false,false); RESC();
  { float sacc=INNER(pB1,3); sacc=__builtin_fmaf(sacc,uB1,INNER(pB1,2)); sacc=__builtin_fmaf(sacc,uB1,INNER(pB1,1)); sacc=__builtin_fmaf(sacc,uB1,INNER(pB1,0)); sacc=__builtin_fmaf(sacc,uB1,INNER(pB0,3)); sacc=__builtin_fmaf(sacc,uB1,INNER(pB0,2)); sacc=__builtin_fmaf(sacc,uB1,INNER(pB0,1)); sacc=__builtin_fmaf(sacc,uB1,INNER(pB0,0)); l_reg+=sacc;
    pw0=(u32x4){PKW(pB0,0),PKW(pB0,2),PKW(pB0,4),PKW(pB0,6)};pw1=(u32x4){PKW(pB0,8),PKW(pB0,10),PKW(pB0,12),PKW(pB0,14)};pw2=(u32x4){PKW(pB1,0),PKW(pB1,2),PKW(pB1,4),PKW(pB1,6)};pw3=(u32x4){PKW(pB1,8),PKW(pB1,10),PKW(pB1,12),PKW(pB1,14)};
    SBAR(); pv(o,vb0+sl_cur,PAF(0),PAF(1),PAF(2),PAF(3)); }
  #undef PKW
  #undef PAF
  #undef VFR
  #undef PIN
  #undef MX3
  #undef GAPA
  #undef FNOP
  #undef GAPB
  #undef EX
  #undef VRD
  #undef KRD
  #undef STEP
  #undef ENDW
  l_reg*=(hi?__builtin_amdgcn_exp2f(sl2*4.f):1.0f);
  {auto rr=__builtin_amdgcn_permlane32_swap(__float_as_uint(l_reg),__float_as_uint(l_reg),false,false);l_reg=__uint_as_float(rr[0])+__uint_as_float(rr[1]);}
  if(hi==0)wsf[32+r32]=l_reg;asm volatile("s_waitcnt lgkmcnt(0)":::"memory");
  float rli[16];
  #pragma unroll
  for(int r=0;r<16;++r)rli[r]=__builtin_amdgcn_rcpf(wsf[32+crow(r,hi)]);
  bf16*Ow=O+(rowbase+q0+wid*QBLK)*OPITCH+h*D;
  { bf16*stg=(bf16*)(shm+LDS_OST)+wid*2048;
    #pragma unroll
    for(int r=0;r<16;++r){const int orow=crow(r,hi);
      #pragma unroll
      for(int d0=0;d0<2;++d0)stg[orow*64+d0*32+r32]=__float2bfloat16(o[d0][r]*rli[r]);}
    asm volatile("s_waitcnt lgkmcnt(0)":::"memory");
    #pragma unroll
    for(int i=0;i<4;++i){const int row=i*8+(lane>>3),ch=lane&7; const u32x4 v=*(const u32x4*)(stg+row*64+ch*8); ATTN_STORE16(Ow+(long)row*OPITCH+ch*8,v);} }
  asm volatile("s_waitcnt lgkmcnt(0)\n\ts_barrier":::"memory");
  #undef DMA_K
  #undef DMA_V
  #undef CMASK
  #undef START
  #undef RESC
  #undef ROT
  #undef TBIAS
  #undef TBIASQ
  #undef CINITQ
  #undef QF
  #undef USGPR
  #undef INNER
  #undef CINIT
}
constexpr int ATTN_LDS_BYTES=LDS_BYTES;
struct AttnTensors { const char* base; long oQ, oK, oV, oO, oKM; };
struct AttnUnit { int bh; int qb; };
struct StaticOrder {
  int vcu;
  __device__ __forceinline__ explicit StaticOrder(int grid,int block):vcu((block%8)*(grid/8)+block/8){}
  __device__ __forceinline__ bool next(int i,AttnUnit&u)const{ if(i>=4)return false; const int s=vcu&3; u.bh=vcu>>2; u.qb=(i==0)?15-s:(i==1)?8+s:(i==2)?7-s:s; return true; }
  __device__ __forceinline__ void a_ready(const AttnUnit&)const{}
  __device__ __forceinline__ void done(const AttnUnit&)const{}
};
template<class Sched,int THRL=8> __device__ __forceinline__ void attn_phase(char*lds,const AttnTensors&T,const Sched&S,const int wid){
  AttnUnit u;
  for(int i=0;S.next(i,u);++i){ S.a_ready(u); attn_unit<THRL>(u.bh/NHEAD,u.bh%NHEAD,u.qb,(const bf16*)(T.base+T.oQ),(const bf16*)(T.base+T.oK),(const bf16*)(T.base+T.oV),(bf16*)(T.base+T.oO),(const float*)(T.base+T.oKM),lds,wid); S.done(u); }
}
#undef SBAR
#undef WAIT_BAR
}

namespace gla {
typedef short bf16x8 __attribute__((ext_vector_type(8)));
typedef short s16x4 __attribute__((ext_vector_type(4)));
typedef float f32x4 __attribute__((ext_vector_type(4)));
typedef unsigned u32x4 __attribute__((ext_vector_type(4)));
typedef unsigned u32x2 __attribute__((ext_vector_type(2)));
typedef __attribute__((address_space(3))) unsigned char* lptr;
constexpr int S = 4096;
__device__ __forceinline__ s16x4 trd(lptr p) { return __builtin_bit_cast(s16x4, __builtin_amdgcn_ds_read_tr16_b64_v4i16((__attribute__((address_space(3))) s16x4*)p)); }
__device__ __forceinline__ bf16x8 cat8(s16x4 a, s16x4 b) { return (bf16x8){a[0], a[1], a[2], a[3], b[0], b[1], b[2], b[3]}; }
__device__ __forceinline__ unsigned pkbf(float lo, float hi) { return f2bf(lo) | (f2bf(hi) << 16); }
#define GLA_LW() asm volatile("s_waitcnt lgkmcnt(0)" ::: "memory")

struct Tensors { const bf16_t *QG, *KG, *VG, *RGS; const bf16_t* LA;     bf16_t* KVS; float* DEC; const float* g_gn; bf16_t* MIX; };

__device__ __forceinline__ void stage_v_load(const Tensors& T, size_t row0, int hg, int lane, u32x4 (&v)[16]) {
#pragma unroll
    for (int it = 0; it < 16; ++it) { const int id = it * 64 + lane, tok = id >> 4, ch = id & 15; v[it] = *(const u32x4*)(T.VG + (row0 + tok) * 512 + hg * 128 + ch * 8); }
}
__device__ __forceinline__ void stage_v_store(lptr wl, int lane, const u32x4 (&v)[16]) {
#pragma unroll
    for (int it = 0; it < 16; ++it) { const int id = it * 64 + lane, tok = id >> 4, ch = id & 15; *(__attribute__((address_space(3))) u32x4*)(wl + tok * 256 + ch * 16) = v[it]; }
}

__device__ __forceinline__ void tile_load8(const bf16_t* base, int lane, u32x4 (&v)[8]) {
#pragma unroll
    for (int r = 0; r < 8; ++r) v[r] = *(const u32x4*)(base + (size_t)(8 * r + (lane >> 3)) * 256 + 8 * (lane & 7));
}
__device__ __forceinline__ void tile_cols8(lptr sc, int lane, const u32x4 v, unsigned (&o)[8]) {
    *(__attribute__((address_space(3))) u32x4*)(sc + (lane >> 3) * 128 + (lane & 7) * 16) = v;
    GLA_LW();
#pragma unroll
    for (int tk = 0; tk < 8; ++tk) o[tk] = *(const __attribute__((address_space(3))) unsigned short*)(sc + tk * 128 + lane * 2);
    GLA_LW();
}

__device__ __forceinline__ void unit_a(const Tensors& T, int unit, lptr wl, lptr sc, int lane) {
    asm volatile("" : "+v"(lane));
    const int c = unit & 63, hg = (unit >> 6) & 3, b = unit >> 8; const size_t row0 = (size_t)b * S + (size_t)c * 64;
    const int i = lane & 15, g = lane >> 4;
    u32x4 vlo[8];
#pragma unroll
    for (int it = 8; it < 16; ++it) { const int id = it * 64 + lane, tok = id >> 4, ch = id & 15;
        __builtin_amdgcn_global_load_lds((const unsigned*)(T.VG + (row0 + tok) * 512 + hg * 128 + ch * 8), (__attribute__((address_space(3))) unsigned*)(wl + it * 1024), 16, 0, 0); }
#pragma unroll
    for (int it = 0; it < 8; ++it) { const int id = it * 64 + lane, tok = id >> 4, ch = id & 15; vlo[it] = *(const u32x4*)(T.VG + (row0 + tok) * 512 + hg * 128 + ch * 8); }
    {
        float G[64]; unsigned kr[64]; float run = 0.f;
        { u32x4 lw[8], kw[8]; tile_load8(T.LA + row0 * 256 + hg * 64, lane, lw); tile_load8(T.KG + row0 * 256 + hg * 64, lane, kw);
          __builtin_amdgcn_sched_barrier(0);
#pragma unroll
          for (int r = 0; r < 8; ++r) { unsigned o[8]; tile_cols8(sc, lane, lw[r], o);
#pragma unroll
              for (int tk = 0; tk < 8; ++tk) G[8 * r + tk] = __uint_as_float(o[tk] << 16); }
#pragma unroll
          for (int r = 0; r < 8; ++r) { unsigned o[8]; tile_cols8(sc, lane, kw[r], o);
#pragma unroll
              for (int tk = 0; tk < 8; ++tk) kr[8 * r + tk] = o[tk]; } }
#pragma unroll
        for (int t = 0; t < 64; ++t) { run += G[t]; G[t] = run; }
        const float gl = run;
#pragma unroll
        for (int t8 = 0; t8 < 8; ++t8) { float kt[8];
#pragma unroll
            for (int j = 0; j < 8; ++j) kt[j] = __uint_as_float(kr[8 * t8 + j] << 16) * __expf(gl - G[8 * t8 + j]);
            u32x4 w; w.x = pkbf(kt[0], kt[1]); w.y = pkbf(kt[2], kt[3]); w.z = pkbf(kt[4], kt[5]); w.w = pkbf(kt[6], kt[7]);
            *(__attribute__((address_space(3))) u32x4*)(wl + lane * 128 + t8 * 16) = w; }
        T.DEC[(size_t)unit * 64 + lane] = __expf(gl);
    }
    GLA_LW();
    bf16x8 afr[4][2];
#pragma unroll
    for (int mt = 0; mt < 4; ++mt)
#pragma unroll
        for (int ks = 0; ks < 2; ++ks) afr[mt][ks] = *(const __attribute__((address_space(3))) bf16x8*)(wl + (16 * mt + i) * 128 + (32 * ks + 8 * g) * 2);
    GLA_LW(); asm volatile("" ::: "memory");
#pragma unroll
    for (int it = 0; it < 8; ++it) *(__attribute__((address_space(3))) u32x4*)(wl + it * 1024 + lane * 16) = vlo[it];
    asm volatile("s_waitcnt vmcnt(0)" ::: "memory");
    GLA_LW(); asm volatile("" ::: "memory");
    bf16_t* kvo = T.KVS + (size_t)unit * 128 * 64;
#pragma unroll
    for (int nt = 0; nt < 8; ++nt) {
        f32x4 acc[4];
#pragma unroll
        for (int mt = 0; mt < 4; ++mt) acc[mt] = (f32x4){0.f, 0.f, 0.f, 0.f};
#pragma unroll
        for (int ks = 0; ks < 2; ++ks) {
            const lptr vb = wl + (32 * ks + 8 * g + (i >> 2)) * 256 + (16 * nt + 4 * (i & 3)) * 2;
            const s16x4 lo = trd(vb), hi = trd(vb + 4 * 256); const bf16x8 bfr = cat8(lo, hi);
#pragma unroll
            for (int mt = 0; mt < 4; ++mt) acc[mt] = __builtin_amdgcn_mfma_f32_16x16x32_bf16(afr[mt][ks], bfr, acc[mt], 0, 0, 0);
        }
        u32x2 w[4];
#pragma unroll
        for (int mt = 0; mt < 4; ++mt) { w[mt].x = pkbf(acc[mt][0], acc[mt][1]); w[mt].y = pkbf(acc[mt][2], acc[mt][3]); }
#pragma unroll
        for (int mp = 0; mp < 2; ++mp) {
            u32x2 a = w[2 * mp], b = w[2 * mp + 1];
            { auto r0 = __builtin_amdgcn_permlane16_swap(a.x, b.x, false, false); a.x = r0[0]; b.x = r0[1]; auto r1 = __builtin_amdgcn_permlane16_swap(a.y, b.y, false, false); a.y = r1[0]; b.y = r1[1]; }
            *(u32x4*)(kvo + (size_t)(16 * nt + i) * 64 + 16 * (2 * mp + (g & 1)) + 4 * (g - (g & 1))) = (u32x4){a.x, a.y, b.x, b.y}; }
    }
    GLA_LW(); asm volatile("" ::: "memory");
}

__device__ __forceinline__ void scan_item(const Tensors& T, int item  , int lane) {
    const int bh = item >> 5, e0 = (item & 31) * 256 + lane * 4, dk = e0 & 63;
    float s0 = 0.f, s1 = 0.f, s2 = 0.f, s3 = 0.f;
    bf16_t* p = T.KVS + (size_t)bh * 64 * 8192 + e0; const float* d = T.DEC + (size_t)bh * 64 * 64 + dk;
#pragma unroll 16
    for (int c = 0; c < 64; ++c) {
        const u32x2 kv = *(const u32x2*)(p + (size_t)c * 8192); const f32x4 dc = *(const f32x4*)(d + c * 64);
        u32x2 o; o.x = pkbf(s0, s1); o.y = pkbf(s2, s3); *(u32x2*)(p + (size_t)c * 8192) = o;
        s0 = dc[0] * s0 + __uint_as_float(kv.x << 16); s1 = dc[1] * s1 + __uint_as_float(kv.x & 0xffff0000u);
        s2 = dc[2] * s2 + __uint_as_float(kv.y << 16); s3 = dc[3] * s3 + __uint_as_float(kv.y & 0xffff0000u);
    }
}

__device__ __forceinline__ void unit_c(const Tensors& T, int unit, lptr wl, int lane) {
    asm volatile("" : "+v"(lane));
    const int c = unit & 63, hg = (unit >> 6) & 3, b = unit >> 8; const size_t row0 = (size_t)b * S + (size_t)c * 64;
    const int i = lane & 15, g = lane >> 4;
    u32x4 vreg[16]; stage_v_load(T, row0, hg, lane, vreg);
    {
        const bf16_t* la = T.LA + row0 * 256 + hg * 64 + lane; const bf16_t* qp = T.QG + row0 * 256 + hg * 64 + lane; const bf16_t* kp = T.KG + row0 * 256 + hg * 64 + lane;
        float run = 0.f;
#pragma unroll
        for (int hb = 0; hb < 2; ++hb) {
            float lav[32]; unsigned qr[32], kr[32];
#pragma unroll
            for (int t = 0; t < 32; ++t) { lav[t] = __uint_as_float((unsigned)la[(size_t)(32 * hb + t) * 256] << 16); qr[t] = qp[(size_t)(32 * hb + t) * 256]; kr[t] = kp[(size_t)(32 * hb + t) * 256]; }
            __builtin_amdgcn_sched_barrier(0);
#pragma unroll
            for (int t8 = 0; t8 < 4; ++t8) { float qd[8], kd[8];
#pragma unroll
                for (int j = 0; j < 8; ++j) { const int t = 8 * t8 + j; run += lav[t]; const float eg = __expf(run);
                    qd[j] = __uint_as_float(qr[t] << 16) * 0.125f * eg; kd[j] = __uint_as_float(kr[t] << 16) * __builtin_amdgcn_rcpf(eg); }
                u32x4 w; w.x = pkbf(qd[0], qd[1]); w.y = pkbf(qd[2], qd[3]); w.z = pkbf(qd[4], qd[5]); w.w = pkbf(qd[6], qd[7]);
                *(__attribute__((address_space(3))) u32x4*)(wl + lane * 128 + (4 * hb + t8) * 16) = w;
                w.x = pkbf(kd[0], kd[1]); w.y = pkbf(kd[2], kd[3]); w.z = pkbf(kd[4], kd[5]); w.w = pkbf(kd[6], kd[7]);
                *(__attribute__((address_space(3))) u32x4*)(wl + 8192 + lane * 128 + (4 * hb + t8) * 16) = w; }
            asm volatile("" ::: "memory");
        }
    }
    GLA_LW(); asm volatile("" ::: "memory");
    bf16x8 qdf[4][2], kdf[4][2];
#pragma unroll
    for (int tt = 0; tt < 4; ++tt)
#pragma unroll
        for (int ks = 0; ks < 2; ++ks) { const lptr qb = wl + (32 * ks + 8 * g + (i >> 2)) * 128 + (16 * tt + 4 * (i & 3)) * 2;
            qdf[tt][ks] = cat8(trd(qb), trd(qb + 4 * 128)); kdf[tt][ks] = cat8(trd(qb + 8192), trd(qb + 8192 + 4 * 128)); }
    GLA_LW(); asm volatile("" ::: "memory");
    stage_v_store(wl, lane, vreg);
    const bf16_t* sp = T.KVS + (size_t)unit * 8192;
    bf16x8 sf[8][2];
#pragma unroll
    for (int dvt = 0; dvt < 8; ++dvt)
#pragma unroll
        for (int ks = 0; ks < 2; ++ks) sf[dvt][ks] = *(const bf16x8*)(sp + (size_t)(16 * dvt + i) * 64 + 32 * ks + 8 * g);
    __builtin_amdgcn_sched_barrier(0);
    u32x2 at[4][4];
#pragma unroll
    for (int it = 0; it < 4; ++it)
#pragma unroll
        for (int jt = 0; jt < 4; ++jt) {
            if (jt > it) { at[it][jt] = (u32x2){0u, 0u}; continue; }
            f32x4 a = (f32x4){0.f, 0.f, 0.f, 0.f};
#pragma unroll
            for (int ks = 0; ks < 2; ++ks) a = __builtin_amdgcn_mfma_f32_16x16x32_bf16(kdf[jt][ks], qdf[it][ks], a, 0, 0, 0);
            if (jt == it) {
#pragma unroll
                for (int r = 0; r < 4; ++r) a[r] = (4 * g + r > i) ? 0.f : a[r]; }
            at[it][jt].x = pkbf(a[0], a[1]); at[it][jt].y = pkbf(a[2], a[3]);
        }
    GLA_LW(); asm volatile("" ::: "memory");
#pragma unroll
    for (int it = 0; it < 4; ++it) {
        f32x4 acc[8]; float ss = 0.f;
        u32x4 rgq[4];
#pragma unroll
        for (int dvp = 0; dvp < 4; ++dvp) rgq[dvp] = *(const u32x4*)(T.RGS + (row0 + 16 * it + i) * 512 + hg * 128 + 16 * (2 * dvp + (g & 1)) + 4 * (g - (g & 1)));
        __builtin_amdgcn_sched_barrier(0);
#pragma unroll
        for (int dvt = 0; dvt < 8; ++dvt) {
            f32x4 a = (f32x4){0.f, 0.f, 0.f, 0.f};
#pragma unroll
            for (int ks = 0; ks < 2; ++ks) a = __builtin_amdgcn_mfma_f32_16x16x32_bf16(sf[dvt][ks], qdf[it][ks], a, 0, 0, 0);
#pragma unroll
            for (int ks = 0; ks < 2; ++ks) { if (2 * ks > it) continue;
                const lptr vb = wl + (32 * ks + 4 * g + (i >> 2)) * 256 + (16 * dvt + 4 * (i & 3)) * 2;
                const bf16x8 vfr = cat8(trd(vb), trd(vb + 16 * 256));
                const u32x2 b0 = at[it][2 * ks], b1 = at[it][2 * ks + 1]; const u32x4 bw = (u32x4){b0.x, b0.y, b1.x, b1.y};
                a = __builtin_amdgcn_mfma_f32_16x16x32_bf16(vfr, __builtin_bit_cast(bf16x8, bw), a, 0, 0, 0); }
            acc[dvt] = a; ss += (a[0] * a[0] + a[1] * a[1]) + (a[2] * a[2] + a[3] * a[3]);
        }
        ss += __shfl_xor(ss, 16); ss += __shfl_xor(ss, 32);
        const float rn = 1.0f / sqrtf(ss * (1.0f / 128.0f) + 1e-6f);
        const size_t tok = row0 + 16 * it + i;
#pragma unroll
        for (int dvp = 0; dvp < 4; ++dvp) { u32x2 wo[2];
            u32x2 rlo = (u32x2){rgq[dvp].x, rgq[dvp].y}, rhi = (u32x2){rgq[dvp].z, rgq[dvp].w};
            { auto r0 = __builtin_amdgcn_permlane16_swap(rlo.x, rhi.x, false, false); rlo.x = r0[0]; rhi.x = r0[1]; auto r1 = __builtin_amdgcn_permlane16_swap(rlo.y, rhi.y, false, false); rlo.y = r1[0]; rhi.y = r1[1]; }
#pragma unroll
            for (int q = 0; q < 2; ++q) { const int dvt = 2 * dvp + q, dv = 16 * dvt + 4 * g; const f32x4 gg = *(const f32x4*)(T.g_gn + dv); const u32x2 rg = q ? rhi : rlo;
                const float o0 = acc[dvt][0] * rn * gg[0] * __uint_as_float(rg.x << 16), o1 = acc[dvt][1] * rn * gg[1] * __uint_as_float(rg.x & 0xffff0000u);
                const float o2 = acc[dvt][2] * rn * gg[2] * __uint_as_float(rg.y << 16), o3 = acc[dvt][3] * rn * gg[3] * __uint_as_float(rg.y & 0xffff0000u);
                wo[q].x = pkbf(o0, o1); wo[q].y = pkbf(o2, o3); }
            { auto r0 = __builtin_amdgcn_permlane16_swap(wo[0].x, wo[1].x, false, false); wo[0].x = r0[0]; wo[1].x = r0[1]; auto r1 = __builtin_amdgcn_permlane16_swap(wo[0].y, wo[1].y, false, false); wo[0].y = r1[0]; wo[1].y = r1[1]; }
            *(u32x4*)(T.MIX + tok * 1024 + 512 + hg * 128 + 16 * (2 * dvp + (g & 1)) + 4 * (g - (g & 1))) = (u32x4){wo[0].x, wo[0].y, wo[1].x, wo[1].y}; }
    }
    GLA_LW(); asm volatile("" ::: "memory");
}
#undef GLA_LW
}

#define GAS __attribute__((address_space(1)))
#define LAS __attribute__((address_space(3)))
typedef unsigned v4u __attribute__((ext_vector_type(4)));
typedef unsigned v2u __attribute__((ext_vector_type(2)));
typedef float f32x4 __attribute__((ext_vector_type(4)));
typedef GAS unsigned gu32;
#define RLX_AGENT __ATOMIC_RELAXED, __HIP_MEMORY_SCOPE_AGENT
#define LDS_WAIT() asm volatile("s_waitcnt lgkmcnt(0)" ::: "memory")
#define VM_WAIT() asm volatile("s_waitcnt vmcnt(0)" ::: "memory")
__device__ __forceinline__ unsigned pk2(float lo, float hi) { return f2bf(lo) | (f2bf(hi) << 16); }


#define XB_TMO      128
#define XB_XCNT(j)  (256  + 64 * (j))
#define XB_XSUB(j)  (1280 + 64 * (j))
#define XB_XGEN(j)  (2304 + 64 * (j))
#define XB_TOP      3328
#define XB_TOPGEN   3392
#define XCD_BAR_WORDS 3456
#define XB_SPIN_CAP (1u << 18)

__device__ __forceinline__ unsigned xb_ld(unsigned* p)              { return __hip_atomic_load(p, __ATOMIC_RELAXED, __HIP_MEMORY_SCOPE_AGENT); }
__device__ __forceinline__ unsigned xb_add(unsigned* p, unsigned v) { return __hip_atomic_fetch_add(p, v, __ATOMIC_RELAXED, __HIP_MEMORY_SCOPE_AGENT); }
__device__ __forceinline__ unsigned xb_xcc_id() { return (unsigned)__builtin_amdgcn_s_getreg((3 << 11) | 20) & 0xFu; }
#define XB_SPIN(cond, bar) do { unsigned _sp = 0; while (cond) { __builtin_amdgcn_s_sleep(1); \
    if ((++_sp & 255u) == 0u) { if (xb_ld(&(bar)[XB_TMO])) break; if (_sp > XB_SPIN_CAP) { atomicAdd(&(bar)[XB_TMO], 1u); break; } } } } while (0)

struct XcdBarrier {
    unsigned* bar; unsigned x;
    volatile LAS unsigned* st;
};

__device__ __forceinline__ XcdBarrier xcd_barrier_post(unsigned* bar, volatile LAS unsigned* st, const bool leader) {
    XcdBarrier b; b.bar = bar; b.x = xb_xcc_id(); b.st = st;
    if (leader) (void)xb_add(&bar[XB_XCNT(b.x)], 1u);
    return b;
}
__device__ __forceinline__ void xcd_barrier_complete(unsigned* bar, unsigned x, unsigned& nloc, unsigned& nx) {
    const unsigned G = gridDim.x * gridDim.y * gridDim.z;
    unsigned sum, cnt, mine, sp = 0u;
    for (;;) {
        sum = 0u; cnt = 0u; mine = 0u;
#pragma unroll
        for (unsigned j = 0; j < 16; ++j) { const unsigned c = xb_ld(&bar[XB_XCNT(j)]); sum += c; cnt += (c > 0u) ? 1u : 0u; mine = (j == x) ? c : mine; }
        if (sum == G) break;
        __builtin_amdgcn_s_sleep(1);
        if ((++sp & 255u) == 0u) { if (xb_ld(&bar[XB_TMO])) break; if (sp > XB_SPIN_CAP) { atomicAdd(&bar[XB_TMO], 1u); break; } }
    }
    nloc = mine > 0u ? mine : 1u; nx = cnt > 0u ? cnt : 1u;
}

__device__ __forceinline__ void xcd_barrier(const XcdBarrier& b, const bool leader) {
    asm volatile("s_waitcnt vmcnt(0)" ::: "memory");
    __syncthreads();
    if (leader) {
        unsigned* bar = b.bar;
        __builtin_amdgcn_s_waitcnt(0);
        unsigned nloc = b.st[0], nx = b.st[1];
        if (nloc == 0u) { xcd_barrier_complete(bar, b.x, nloc, nx); b.st[0] = nloc; b.st[1] = nx; }
        const unsigned old = xb_add(&bar[XB_XSUB(b.x)], 1u);
        const unsigned gen = old / nloc;
        if (old == gen * nloc && nloc > 1u) {
            __builtin_amdgcn_fence(__ATOMIC_RELEASE, "agent");
            asm volatile("s_waitcnt vmcnt(0)" ::: "memory");
        }
        if (old + 1u == (gen + 1u) * nloc) {
            __builtin_amdgcn_fence(__ATOMIC_RELEASE, "agent");
            asm volatile("s_waitcnt vmcnt(0)" ::: "memory");
            const unsigned og = xb_add(&bar[XB_TOP], 1u);
            const unsigned tg = og / nx;
            if (og + 1u == (tg + 1u) * nx) xb_add(&bar[XB_TOPGEN], 1u);
            else XB_SPIN(xb_ld(&bar[XB_TOPGEN]) == tg, bar);
            __builtin_amdgcn_fence(__ATOMIC_ACQUIRE, "agent");
            xb_add(&bar[XB_XGEN(b.x)], 1u);
            asm volatile("s_waitcnt vmcnt(0)" ::: "memory");
        } else {
            XB_SPIN(xb_ld(&bar[XB_XGEN(b.x)]) == gen, bar);
            __builtin_amdgcn_fence(__ATOMIC_ACQUIRE, "agent");
            asm volatile("s_waitcnt vmcnt(0)" ::: "memory");
        }
    }
    __syncthreads();
}

#ifndef DBG_NOKM
#define DBG_NOKM 0
#endif
#ifndef DBG_NOLA
#define DBG_NOLA 0
#endif
#ifndef DBG_NOMID
#define DBG_NOMID 0
#endif
#ifndef DBG_NOPLE
#define DBG_NOPLE 0
#endif
#ifndef DBG_NOPROJ
#define DBG_NOPROJ 0
#endif
#ifndef PROBE_REP_PHASE
#define PROBE_REP_PHASE -1
#endif
#ifndef PROBE_REP_N
#define PROBE_REP_N 2
#endif
#ifndef MOE2_F8
#define MOE2_F8 true
#endif
namespace mk {
using pg8::Unit;
constexpr int NWAVES = 8, NPHASES = 12;
constexpr int B = 8, S = 4096, D = 1024, T = B * S, NPROJ = 3328;
constexpr float LOG2E = 1.4426950408889634f, C2 = 0.125f * LOG2E, EPS = 1e-6f;
constexpr size_t MiB = 1u << 20;
constexpr size_t WS_CTL = 0, CTL_ZERO_BYTES = 80 * 1024;
constexpr size_t WS_DEC = 1 * MiB, WS_RPLE = 1 * MiB + 512 * 1024;
constexpr size_t WS_WIN = 2 * MiB, WS_WOUT = 9 * MiB, WS_WPG = 11 * MiB, WS_WPP = 13 * MiB;
constexpr size_t WS_WR = 13 * MiB + 512 * 1024, WS_KMEAN = 13 * MiB + 768 * 1024;
constexpr size_t WS_SSQ_PLE = 14 * MiB, WS_SSQ_H1 = 16 * MiB, WS_SSQ_H3 = 18 * MiB;
constexpr size_t WS_LIST = 20 * MiB, WS_RLIST = 24 * MiB, WS_GLIST = 28 * MiB, WS_TOPE = 32 * MiB, WS_TPOS = 33 * MiB;
constexpr size_t WS_W1 = 34 * MiB, WS_W2 = 162 * MiB, WS_H1F8 = 194 * MiB;
constexpr size_t WS_PPRE = 226 * MiB, WS_H1 = 290 * MiB;
constexpr size_t WS_XN = 354 * MiB, WS_PB = 418 * MiB, WS_QA = 434 * MiB, WS_KA = 466 * MiB, WS_VA = 498 * MiB, WS_QG = 530 * MiB, WS_KG = 546 * MiB, WS_VG = 562 * MiB, WS_RGS = 594 * MiB, WS_LA = 626 * MiB;
constexpr size_t WS_MIX = 658 * MiB, WS_KVS = 722 * MiB;
constexpr size_t WS_HID = 354 * MiB, WS_Y = 626 * MiB;
constexpr size_t WS_H3 = 354 * MiB, WS_H2F8 = WS_H1F8, WS_H2 = 898 * MiB;
static_assert(WS_VA - WS_KA == WS_KA - WS_QA && WS_KG - WS_QG == 16 * MiB && WS_RGS - WS_VG == 32 * MiB, "ws map");
constexpr int HROWS = (T * 4 / 256 + 32) * 256;
static_assert(WS_HID + (size_t)HROWS * 1024 * 2 <= WS_Y && WS_Y + (size_t)HROWS * 1024 * 2 <= 1024 * MiB && WS_KVS + 32 * MiB <= 1024 * MiB, "ws map 2");
constexpr int CW_TMO = 0, CW_CODE = 1, CW_BAR = 4096, CW_CNT = 16384;
constexpr int RING_OFF = 0, RING_BYTES = 131072, LDSCTL_OFF = RING_BYTES, MISC_OFF = LDSCTL_OFF + 320, TAB_OFF = LDSCTL_OFF + 1024  , LDS_BYTES = 147456;

typedef const __attribute__((address_space(4))) char* kptr_t;
__device__ __forceinline__ const float* mk_karg(kptr_t kp, int off) { asm volatile("" : "+s"(kp)); return *(const float* const __attribute__((address_space(4)))*)(kp + off); }
#define INP(i) mk_karg(F.kp, 8 * (i))
struct Frame {
    LAS unsigned char* lds; volatile LAS unsigned* MISC; gu32* ctl;
    int wave, vcu, G;
    kptr_t kp;
    unsigned char* ws;
};
__device__ __forceinline__ float wave_sum(float v) {
#pragma unroll
    for (int o = 1; o < 64; o <<= 1) v += __shfl_xor(v, o);
    return v;
}

__device__ __forceinline__ void p0_tile(const float* W, int ldw, int k0, int n0, bf16_t* WT, int ldt, int trow, const float* ksc, LAS float* scr, int lane) {
#pragma unroll
    for (int i = 0; i < 8; ++i) { const int kk = 8 * i + (lane >> 3), nn = 4 * (lane & 7);
        f32x4 v = *(const GAS f32x4*)(W + (size_t)(k0 + kk) * ldw + n0 + nn); if (ksc) v = v * ksc[k0 + kk];
        scr[kk * 33 + nn] = v.x; scr[kk * 33 + nn + 1] = v.y; scr[kk * 33 + nn + 2] = v.z; scr[kk * 33 + nn + 3] = v.w; }
    LDS_WAIT(); asm volatile("" ::: "memory");
    const int c = lane >> 3, nl = lane & 7;
#pragma unroll
    for (int j = 0; j < 4; ++j) { const int n = 8 * j + nl; const LAS float* s = scr + (8 * c) * 33 + n;
        v4u o; o.x = pk2(s[0 * 33], s[1 * 33]); o.y = pk2(s[2 * 33], s[3 * 33]); o.z = pk2(s[4 * 33], s[5 * 33]); o.w = pk2(s[6 * 33], s[7 * 33]);
        *(GAS v4u*)(WT + (size_t)(trow + n0 + n) * ldt + k0 + 8 * c) = o; }
    LDS_WAIT(); asm volatile("" ::: "memory");
}
__device__ __forceinline__ void p0_tile_f8(const float* W, int ldw, int k0, int n0, unsigned char* WT8, int ldt, const float* ksc, float mul, LAS float* scr, int lane) {
#pragma unroll
    for (int i = 0; i < 8; ++i) { const int kk = 8 * i + (lane >> 3), nn = 4 * (lane & 7);
        f32x4 v = *(const GAS f32x4*)(W + (size_t)(k0 + kk) * ldw + n0 + nn); v = v * (ksc ? ksc[k0 + kk] * mul : mul);
        scr[kk * 33 + nn] = v.x; scr[kk * 33 + nn + 1] = v.y; scr[kk * 33 + nn + 2] = v.z; scr[kk * 33 + nn + 3] = v.w; }
    LDS_WAIT(); asm volatile("" ::: "memory");
    const int c = lane >> 3, nl = lane & 7;
#pragma unroll
    for (int j = 0; j < 4; ++j) { const int n = 8 * j + nl; const LAS float* s = scr + (8 * c) * 33 + n;
        v2u o; o.x = pg8::pk4_fp8(s[0 * 33], s[1 * 33], s[2 * 33], s[3 * 33]); o.y = pg8::pk4_fp8(s[4 * 33], s[5 * 33], s[6 * 33], s[7 * 33]);
        *(GAS v2u*)(WT8 + (size_t)(n0 + n) * ldt + k0 + 8 * c) = o; }
    LDS_WAIT(); asm volatile("" ::: "memory");
}
__device__ __forceinline__ void p0_comb_tile(const float* w_in, const float* w_gg, int k0, int n0, bf16_t* WT, LAS float* scr, int lane) {
    const int jj = lane & 31; float g[16];
#pragma unroll
    for (int r = 0; r < 16; ++r) g[r] = w_gg[r * 256 + n0 + jj];
    for (int i = 0; i < 32; ++i) { const int kk = 2 * i + (lane >> 5); const float* wr = w_in + (size_t)(k0 + kk) * 3088 + 3072; float s = 0.f;
#pragma unroll
        for (int r = 0; r < 16; ++r) s += wr[r] * g[r];
        scr[kk * 33 + jj] = s; }
    LDS_WAIT(); asm volatile("" ::: "memory");
    const int c = lane >> 3, nl = lane & 7;
#pragma unroll
    for (int j = 0; j < 4; ++j) { const int n = 8 * j + nl; const LAS float* s = scr + (8 * c) * 33 + n;
        v4u o; o.x = pk2(s[0 * 33], s[1 * 33]); o.y = pk2(s[2 * 33], s[3 * 33]); o.z = pk2(s[4 * 33], s[5 * 33]); o.w = pk2(s[6 * 33], s[7 * 33]);
        *(GAS v4u*)(WT + (size_t)(3072 + n0 + n) * 1024 + k0 + 8 * c) = o; }
    LDS_WAIT(); asm volatile("" ::: "memory");
}
struct P0TD { const float* src; const float* ksc; unsigned char* dst; int ldw; };
__device__ __forceinline__ P0TD p0_w12_decode(int r, const float* w1, const float* w2, const float* gffn, unsigned char* W1_8, unsigned char* W2_8) {
    P0TD d;
    if (r < 32 * 8 * 64) { const int e = r >> 9, q = r & 511, k0 = 128 * (q >> 6), n0 = 32 * (q & 63); d.src = w1 + (size_t)e * 1024 * 2048 + (size_t)k0 * 2048 + n0; d.ldw = 2048; d.ksc = gffn + k0; d.dst = W1_8 + (size_t)e * 2048 * 1024 + (size_t)n0 * 1024 + k0; }
    else { r -= 32 * 8 * 64; const int e = r >> 8, q = r & 255, k0 = 128 * (q >> 5), n0 = 32 * (q & 31); d.src = w2 + (size_t)e * 1024 * 1024 + (size_t)k0 * 1024 + n0; d.ldw = 1024; d.ksc = nullptr; d.dst = W2_8 + (size_t)e * 1024 * 1024 + (size_t)n0 * 1024 + k0; }
    return d;
}
__device__ __forceinline__ void p0_w12_load(const P0TD& d, int lane, f32x4 (&v)[16], float (&sc)[16]) {
#pragma unroll
    for (int i = 0; i < 16; ++i) { const int kk = 32 * (i >> 2) + 4 * (lane >> 3) + (i & 3); v[i] = __builtin_nontemporal_load((const GAS f32x4*)(d.src + (size_t)kk * d.ldw + 4 * (lane & 7))); sc[i] = d.ksc ? d.ksc[kk] * 64.0f : 64.0f; }
}
__device__ __forceinline__ void p0_w12_store(const P0TD& d, int lane, const f32x4 (&v)[16], const float (&sc)[16], LAS float* scr) {
    LAS unsigned* s32 = (LAS unsigned*)scr;
#pragma unroll
    for (int g = 0; g < 4; ++g)
#pragma unroll
        for (int c = 0; c < 4; ++c)
            s32[(4 * (lane & 7) + c) * 33 + (lane >> 3) + 8 * g] = pg8::pk4_fp8(v[4 * g][c] * sc[4 * g], v[4 * g + 1][c] * sc[4 * g + 1], v[4 * g + 2][c] * sc[4 * g + 2], v[4 * g + 3][c] * sc[4 * g + 3]);
    LDS_WAIT(); asm volatile("" ::: "memory");
#pragma unroll
    for (int r = 0; r < 4; ++r) { const int n = 8 * r + (lane >> 3), p4 = 4 * (lane & 7); const LAS unsigned* s = s32 + n * 33 + p4;
        v4u o; o.x = s[0]; o.y = s[1]; o.z = s[2]; o.w = s[3];
        __builtin_nontemporal_store(o, (GAS v4u*)(d.dst + (size_t)n * 1024 + 4 * p4)); }
    LDS_WAIT(); asm volatile("" ::: "memory");
}
#ifndef PROBE_P0MODE
#define PROBE_P0MODE 0
#endif
__device__ __forceinline__ void p0_prologue(Frame& F, const int mode = 0) {
    LAS float* scr = (LAS float*)(F.lds + RING_OFF + F.wave * 16384);
    const int gw = F.vcu * NWAVES + F.wave, NGW = F.G * NWAVES, lane = mk_lane_id();
    const float *in_x = INP(0), *in_p = INP(1), *in_gmix = INP(2), *in_win = INP(3), *in_wgg = INP(4), *in_wout = INP(7), *in_gffn = INP(8), *in_wr = INP(9), *in_w1 = INP(11), *in_w2 = INP(13), *in_wpg = INP(15), *in_wpp = INP(16);
    bf16_t* WIN_T = (bf16_t*)(F.ws + WS_WIN); bf16_t* WOUT_T = (bf16_t*)(F.ws + WS_WOUT); bf16_t* WPG_T = (bf16_t*)(F.ws + WS_WPG); bf16_t* WPP_T = (bf16_t*)(F.ws + WS_WPP);
    bf16_t* WR_T = (bf16_t*)(F.ws + WS_WR); unsigned char* W1_8 = F.ws + WS_W1; unsigned char* W2_8 = F.ws + WS_W2;
    constexpr int I_WIN = 16 * 96, I_COMB = 16 * 8, I_WOUT = 16 * 32, I_WPG = 16 * 32, I_WPP = 4 * 32, I_WR = 16, I_W1 = 32 * 8 * 64, I_W2 = 32 * 8 * 32;
    constexpr int NITEMS = I_WIN + I_COMB + I_WOUT + I_WPG + I_WPP + I_WR;
    if (PROBE_P0MODE == 0 || mode == 0)
    for (int it = gw; it < NITEMS; it += NGW) {
        int r = it;
        if (r < I_WIN) { p0_tile(in_win, 3088, 64 * (r / 96), 32 * (r % 96), WIN_T, 1024, 0, nullptr, scr, lane); continue; } r -= I_WIN;
        if (r < I_COMB) { p0_comb_tile(in_win, in_wgg, 64 * (r / 8), 32 * (r % 8), WIN_T, scr, lane); continue; } r -= I_COMB;
        if (r < I_WOUT) { p0_tile(in_wout, 1024, 64 * (r / 32), 32 * (r % 32), WOUT_T, 1024, 0, nullptr, scr, lane); continue; } r -= I_WOUT;
        if (r < I_WPG) { p0_tile_f8(in_wpg, 1024, 64 * (r / 32), 32 * (r % 32), (unsigned char*)WPG_T, 1024, nullptr, 64.0f, scr, lane); continue; } r -= I_WPG;
        if (r < I_WPP) { p0_tile_f8(in_wpp, 1024, 64 * (r / 32), 32 * (r % 32), (unsigned char*)WPP_T, 256, nullptr, 64.0f, scr, lane); continue; } r -= I_WPP;
        { p0_tile(in_wr, 32, 64 * r, 0, WR_T, 1024, 0, in_gffn, scr, lane); }
    }
    {
        constexpr int NW12 = I_W1 + I_W2;
        int it = gw;
#if PROBE_P0MODE == 2
        if (mode) { float accs = 0.f;
#pragma unroll 1
            for (; it < NW12; it += NGW) { P0TD d0 = p0_w12_decode(it, in_w1, in_w2, in_gffn, W1_8, W2_8);
                f32x4 v0[16]; float s0[16]; p0_w12_load(d0, lane, v0, s0);
#pragma unroll
                for (int i = 0; i < 16; ++i) accs += (v0[i].x + v0[i].y) * s0[i] + (v0[i].z + v0[i].w); }
            if (accs == 1.2345e-30f) scr[lane] = accs;
            return;
        }
#endif
        if (it < NW12) {
            P0TD d0 = p0_w12_decode(it, in_w1, in_w2, in_gffn, W1_8, W2_8); f32x4 v0[16]; float s0[16]; p0_w12_load(d0, lane, v0, s0);
            for (;;) {
                const int itn = it + NGW; const bool more = itn < NW12;
                P0TD d1 = d0; f32x4 v1[16]; float s1[16];
                if (more) { d1 = p0_w12_decode(itn, in_w1, in_w2, in_gffn, W1_8, W2_8); p0_w12_load(d1, lane, v1, s1); }
                p0_w12_store(d0, lane, v0, s0, scr);
                if (!more) break;
                d0 = d1; it = itn;
#pragma unroll
                for (int i = 0; i < 16; ++i) { v0[i] = v1[i]; s0[i] = s1[i]; }
            }
        }
    }
    if (PROBE_P0MODE != 0 && mode != 0) return;
    bf16_t* XN = (bf16_t*)(F.ws + WS_XN);
    {
        f32x4 gm[4];
#pragma unroll
        for (int j = 0; j < 4; ++j) gm[j] = ((const GAS f32x4*)in_gmix)[64 * j + lane];
        int m = gw; f32x4 v[4];
        if (m < T) {
#pragma unroll
            for (int j = 0; j < 4; ++j) v[j] = __builtin_nontemporal_load((const GAS f32x4*)(in_x + (size_t)m * D) + lane + 64 * j);
        }
        while (m < T) {
            const int mn = m + NGW; f32x4 vn[4];
            if (mn < T) {
#pragma unroll
                for (int j = 0; j < 4; ++j) vn[j] = __builtin_nontemporal_load((const GAS f32x4*)(in_x + (size_t)mn * D) + lane + 64 * j);
            }
            float s = 0.f;
#pragma unroll
            for (int j = 0; j < 4; ++j) s += (v[j].x * v[j].x + v[j].y * v[j].y) + (v[j].z * v[j].z + v[j].w * v[j].w);
            const float rs = 1.0f / sqrtf(wave_sum(s) * (1.0f / D) + EPS);
            GAS v2u* o8 = (GAS v2u*)(XN + (size_t)m * D) + lane;
#pragma unroll
            for (int j = 0; j < 4; ++j) { v2u o; o.x = pk2(v[j].x * rs * gm[j].x, v[j].y * rs * gm[j].y); o.y = pk2(v[j].z * rs * gm[j].z, v[j].w * rs * gm[j].w); o8[64 * j] = o; }
#pragma unroll
            for (int j = 0; j < 4; ++j) v[j] = vn[j];
            m = mn;
        }
    }
    unsigned char* PB = F.ws + WS_PB;
    for (int m = gw; m < T / 4; m += 2 * NGW) {
        const int m2 = m + NGW; const bool two = m2 < T / 4;
        const GAS f32x4* xr = (const GAS f32x4*)(in_p + (size_t)m * 1024) + lane; const GAS f32x4* xr2 = (const GAS f32x4*)(in_p + (size_t)(two ? m2 : m) * 1024) + lane;
        f32x4 a[4], c[4];
#pragma unroll
        for (int j = 0; j < 4; ++j) { a[j] = __builtin_nontemporal_load(xr + 64 * j); c[j] = __builtin_nontemporal_load(xr2 + 64 * j); }
        GAS unsigned* o8 = (GAS unsigned*)(PB + (size_t)m * 1024) + lane; GAS unsigned* o82 = (GAS unsigned*)(PB + (size_t)m2 * 1024) + lane;
#pragma unroll
        for (int j = 0; j < 4; ++j) o8[64 * j] = pg8::pk4_fp8(a[j].x, a[j].y, a[j].z, a[j].w);
        if (two) {
#pragma unroll
            for (int j = 0; j < 4; ++j) o82[64 * j] = pg8::pk4_fp8(c[j].x, c[j].y, c[j].z, c[j].w); }
    }
    float* KM = (float*)(F.ws + WS_KMEAN);
    for (int i = gw * 64 + lane; i < B * 8 * 16 * 64; i += NGW * 64) KM[i] = 0.f;
}

__device__ __forceinline__ float fast_sigm(float x) { return __builtin_amdgcn_rcpf(1.0f + __expf(-x)); }
struct ProjProb {
    static constexpr bool LIST_DMA = false, PERM64 = true, EPI_DMA = false, PERM = true, F8 = false, GATHER = false; static constexpr int SCALE_A = 0, SCALE_B = 0;
    static constexpr int K = 1024; const bf16_t* A; const bf16_t* Bt; pg8::StaticOrder ord;
    unsigned char* ws; float *LA, *KMEAN; const float* bgg;
    __device__ __forceinline__ bool next(int i, Unit& u) const { if (ord.G != 256) return ord.next(i, u); if (i < 6) return ord.at((long)i * 256 + ord.c, u); if (i == 6 && ord.c >= 128) return ord.at(1536 + (ord.c - 128), u); return false; }
    __device__ __forceinline__ const char* a_base(const Unit& u) const { return (const char*)A + (size_t)u.pm * 256 * K * 2; }
    __device__ __forceinline__ void a_offs(const Unit&, int tid, unsigned (&o)[2][2]) const {
#pragma unroll
        for (int i = 0; i < 2; ++i) { int R, C; pg8::stage_rc(tid * 16 + i * 8192, R, C);
#pragma unroll
            for (int h = 0; h < 2; ++h) o[h][i] = (unsigned)((h * 128 + R) * K + C) * 2u; } }
    __device__ __forceinline__ const char* b_base(const Unit& u) const { return (const char*)Bt + (size_t)u.pn * 256 * K * 2; }
    __device__ __forceinline__ void epilogue(const pg8::f32x4 (&acc)[2][2][4][2], const Unit& u, int wr, int wc, int fr, int fq) const {
        const int row0 = u.pm * 256 + wr * 64 + fr, cw = wc * 64 + 16 * fq, pn = u.pn;
        if (pn < 6) {
            const int which = pn >> 1; bf16_t* base = (bf16_t*)(ws + WS_QA + (size_t)which * (WS_KA - WS_QA)); const int colt = (pn & 1) * 256 + cw;
            const float sl2 = exp2f(-(float)((pn & 1) * 4 + wc + 1)) * LOG2E;
#pragma unroll
            for (int ai = 0; ai < 2; ++ai)
#pragma unroll
                for (int m = 0; m < 4; ++m) { bf16_t* rowp = base + (size_t)(row0 - 8 * (fr >> 3) + ai * 128 + m * 16) * 512 + colt + 8 * (fr >> 3); pg8::u32x4 w[2];
#pragma unroll
                    for (int bj = 0; bj < 2; ++bj) { pg8::f32x4 v0 = acc[ai][bj][m][0], v1 = acc[ai][bj][m][1];
                        float sc = 1.0f; if (which == 0) sc = C2; else if (which == 2) sc = exp2f(sl2 * (float)(16 * m + fr));
                        v0 = v0 * sc; v1 = v1 * sc; w[bj] = pg8::pack8(v0, v1); }
                    pg8::st_rows16(rowp, (size_t)8 * 512, w[0], w[1], fr >= 8); }
            if (which == 1 && !DBG_NOKM) {
                const int b = u.pm >> 4, nb = u.pm & 15;
#pragma unroll
                for (int bj = 0; bj < 2; ++bj)
#pragma unroll
                    for (int n = 0; n < 2; ++n) { pg8::f32x4 cs = (pg8::f32x4){0.f, 0.f, 0.f, 0.f};
#pragma unroll
                        for (int ai = 0; ai < 2; ++ai)
#pragma unroll
                            for (int m = 0; m < 4; ++m) cs = cs + acc[ai][bj][m][n];
#pragma unroll
                        for (int j = 0; j < 4; ++j) { float s = cs[j]; s += __shfl_xor(s, 1); s += __shfl_xor(s, 2); s += __shfl_xor(s, 4); s += __shfl_xor(s, 8);
                            const int col = colt + bj * 8 + 4 * n + j; if (fr == 0) atomicAdd(KMEAN + (((size_t)b * 8 + (col >> 6)) * 16 + nb) * 64 + (col & 63), s * (1.0f / 256.0f)); } }
            }
        } else if (pn < 12 && !DBG_NOMID) {
            bf16_t* base; int ld, colt; bool silu = false;
            if (pn < 8) { base = (bf16_t*)(ws + WS_QG + (size_t)(pn - 6) * (WS_KG - WS_QG)); ld = 256; colt = cw; }
            else { base = (bf16_t*)(ws + WS_VG + (size_t)((pn - 8) >> 1) * (WS_RGS - WS_VG)); ld = 512; colt = ((pn - 8) & 1) * 256 + cw; silu = pn >= 10; }
#pragma unroll
            for (int ai = 0; ai < 2; ++ai)
#pragma unroll
                for (int m = 0; m < 4; ++m) { bf16_t* rowp = base + (size_t)(row0 - 8 * (fr >> 3) + ai * 128 + m * 16) * ld + colt + 8 * (fr >> 3); pg8::u32x4 w[2];
#pragma unroll
                    for (int bj = 0; bj < 2; ++bj) { pg8::f32x4 v0 = acc[ai][bj][m][0], v1 = acc[ai][bj][m][1];
                        if (silu) {
#pragma unroll
                            for (int j = 0; j < 4; ++j) { v0[j] = v0[j] * fast_sigm(v0[j]); v1[j] = v1[j] * fast_sigm(v1[j]); } }
                        w[bj] = pg8::pack8(v0, v1); }
                    pg8::st_rows16(rowp, (size_t)8 * ld, w[0], w[1], fr >= 8); }
        } else if (!DBG_NOLA) {
            pg8::f32x4 bb[2][2];
#pragma unroll
            for (int bj = 0; bj < 2; ++bj) { bb[bj][0] = *(const pg8::f32x4*)(bgg + cw + bj * 8); bb[bj][1] = *(const pg8::f32x4*)(bgg + cw + bj * 8 + 4); }
#pragma unroll
            for (int ai = 0; ai < 2; ++ai)
#pragma unroll
                for (int m = 0; m < 4; ++m) { bf16_t* rowp = (bf16_t*)LA + (size_t)(row0 - 8 * (fr >> 3) + ai * 128 + m * 16) * 256 + cw + 8 * (fr >> 3); pg8::u32x4 w[2];
#pragma unroll
                    for (int bj = 0; bj < 2; ++bj) { pg8::f32x4 v0 = acc[ai][bj][m][0] + bb[bj][0], v1 = acc[ai][bj][m][1] + bb[bj][1];
#pragma unroll
                        for (int j = 0; j < 4; ++j) { v0[j] = (fminf(v0[j], 0.f) - __logf(1.0f + __expf(-fabsf(v0[j])))) * (1.0f / 16.0f); v1[j] = (fminf(v1[j], 0.f) - __logf(1.0f + __expf(-fabsf(v1[j])))) * (1.0f / 16.0f); }
                        w[bj] = pg8::pack8(v0, v1); }
                    pg8::st_rows16(rowp, (size_t)8 * 256, w[0], w[1], fr >= 8); }
        }
    }
};
struct PleProb {
    static constexpr bool LIST_DMA = false, PERM64 = true, EPI_DMA = false, PERM = true, F8 = true, GATHER = true; static constexpr int SCALE_A = 0x7C7C7C7C, SCALE_B = 0x7C7C7C7C;
    static constexpr int K = 128; const unsigned char* A; const unsigned char* Bt; pg8::StaticOrder ord; bf16_t* PPRE; float* SSQP;
    int i0 = 0, n = 4;
    __device__ __forceinline__ bool next(int i, Unit& u) const { if (ord.G != 256) return (i0 == 0) && ord.next(i, u); if (ord.c < 128 && i < n) return ord.at((long)(i0 + i) * 128 + ord.c, u); return false; }
    __device__ __forceinline__ const char* a_base(const Unit&) const { return (const char*)A; }
    __device__ __forceinline__ void a_offs(const Unit& u, int tid, unsigned (&o)[2][2]) const {
#pragma unroll
        for (int i = 0; i < 2; ++i) { int R, C; pg8::stage_rc(tid * 16 + i * 8192, R, C);
#pragma unroll
            for (int h = 0; h < 2; ++h) o[h][i] = (unsigned)((u.pm * 256 + h * 128 + R) * K + C) * 2u; } }
    __device__ __forceinline__ const char* b_base(const Unit& u) const { return (const char*)Bt + (size_t)u.pn * 256 * K * 2; }
    __device__ __forceinline__ void epilogue(const pg8::f32x4 (&acc)[2][2][4][2], const Unit& u, int wr, int wc, int fr, int fq) const {
        const int row0 = u.pm * 256 + wr * 64 + fr, cw = u.pn * 256 + wc * 64 + 16 * fq;
#pragma unroll
        for (int ai = 0; ai < 2; ++ai) { float ssel = 0.f;
#pragma unroll
            for (int m = 0; m < 4; ++m) { const int row = row0 + ai * 128 + m * 16; unsigned char* rowp = (unsigned char*)PPRE + (size_t)row * 1024 + cw; float ss = 0.f; pg8::u32x4 w8;
#pragma unroll
                for (int bj = 0; bj < 2; ++bj) { const pg8::f32x4 v0 = acc[ai][bj][m][0], v1 = acc[ai][bj][m][1];
                    ss += (v0[0] * v0[0] + v0[1] * v0[1]) + (v0[2] * v0[2] + v0[3] * v0[3]) + (v1[0] * v1[0] + v1[1] * v1[1]) + (v1[2] * v1[2] + v1[3] * v1[3]);
                    w8[2 * bj] = pg8::pk4_fp8(v0[0] * 16.0f, v0[1] * 16.0f, v0[2] * 16.0f, v0[3] * 16.0f); w8[2 * bj + 1] = pg8::pk4_fp8(v1[0] * 16.0f, v1[1] * 16.0f, v1[2] * 16.0f, v1[3] * 16.0f); }
                *(pg8::u32x4*)rowp = w8;
                ss += __shfl_xor(ss, 16); ss += __shfl_xor(ss, 32);
                ssel = (fq == m) ? ss : ssel; }
            SSQP[(size_t)(row0 + ai * 128 + fq * 16) * 16 + u.pn * 4 + wc] = ssel; }
    }
};

struct OutProb {
    static constexpr bool LIST_DMA = false, PERM64 = true, EPI_DMA = false, PERM = true, F8 = false, GATHER = false; static constexpr int SCALE_A = 0, SCALE_B = 0;
    static constexpr int K = 1024; const bf16_t* A; const bf16_t* Bt; pg8::StaticOrder ord; const float* X; bf16_t* H1; unsigned char* H1F8; float* SSQ;
    __device__ __forceinline__ bool next(int i, Unit& u) const { return ord.next(i, u); }
    __device__ __forceinline__ const char* a_base(const Unit& u) const { return (const char*)A + (size_t)u.pm * 256 * K * 2; }
    __device__ __forceinline__ void a_offs(const Unit&, int tid, unsigned (&o)[2][2]) const {
#pragma unroll
        for (int i = 0; i < 2; ++i) { int R, C; pg8::stage_rc(tid * 16 + i * 8192, R, C);
#pragma unroll
            for (int h = 0; h < 2; ++h) o[h][i] = (unsigned)((h * 128 + R) * K + C) * 2u; } }
    __device__ __forceinline__ const char* b_base(const Unit& u) const { return (const char*)Bt + (size_t)u.pn * 256 * K * 2; }
    __device__ __forceinline__ void epilogue(const pg8::f32x4 (&acc)[2][2][4][2], const Unit& u, int wr, int wc, int fr, int fq) const {
        const int row0 = u.pm * 256 + wr * 64 + fr, cw = u.pn * 256 + wc * 64 + 16 * fq;
#pragma unroll
        for (int ai = 0; ai < 2; ++ai) { float ssel = 0.f;
#pragma unroll
            for (int m = 0; m < 4; ++m) { const int row = row0 + ai * 128 + m * 16; const size_t off = (size_t)row * 1024 + cw; float ss = 0.f; pg8::u32x4 w8; pg8::u32x4 w[2];
#pragma unroll
                for (int bj = 0; bj < 2; ++bj) { const pg8::f32x4 x0 = *(const pg8::f32x4*)(X + off + bj * 8), x1 = *(const pg8::f32x4*)(X + off + bj * 8 + 4);
                    const pg8::f32x4 v0 = acc[ai][bj][m][0] + x0, v1 = acc[ai][bj][m][1] + x1;
                    ss += (v0[0] * v0[0] + v0[1] * v0[1]) + (v0[2] * v0[2] + v0[3] * v0[3]) + (v1[0] * v1[0] + v1[1] * v1[1]) + (v1[2] * v1[2] + v1[3] * v1[3]);
                    w[bj] = pg8::pack8(v0, v1);
                    w8[2 * bj] = pg8::pk4_fp8(v0[0], v0[1], v0[2], v0[3]); w8[2 * bj + 1] = pg8::pk4_fp8(v1[0], v1[1], v1[2], v1[3]); }
                pg8::st_rows16(H1 + off - (size_t)(8 * (fr >> 3)) * 1024 + 8 * (fr >> 3), (size_t)8 * 1024, w[0], w[1], fr >= 8);
                *(pg8::u32x4*)(H1F8 + off) = w8;
                ss += __shfl_xor(ss, 16); ss += __shfl_xor(ss, 32);
                ssel = (fq == m) ? ss : ssel; }
            SSQ[(size_t)(row0 + ai * 128 + fq * 16) * 16 + (u.pn & 3) * 4 + wc] = ssel; }
    }
};

typedef short bf16x8_t __attribute__((ext_vector_type(8)));
__device__ __forceinline__ void router_phase(Frame& F) {
    const bf16_t* H1 = (const bf16_t*)(F.ws + WS_H1); const bf16_t* WR = (const bf16_t*)(F.ws + WS_WR); const float* SSQ = (const float*)(F.ws + WS_SSQ_H1);
    int* LIST = (int*)(F.ws + WS_LIST); float* RLIST = (float*)(F.ws + WS_RLIST); float* GLIST = (float*)(F.ws + WS_GLIST); int* TOPE = (int*)(F.ws + WS_TOPE); int* TPOS = (int*)(F.ws + WS_TPOS);
    unsigned* CNT = (unsigned*)(F.ctl + CW_CNT); const float* SSQP = (const float*)(F.ws + WS_SSQ_PLE); float* RPLE = (float*)(F.ws + WS_RPLE);
    LAS float* lg = (LAS float*)(F.lds + RING_OFF + 66560 + F.wave * 4096);
    {
#pragma unroll
        for (int q = 0; q < 8; ++q) { const int c = F.wave * 8 + q, row = c >> 1, half = c & 1;
            __builtin_amdgcn_global_load_lds((const unsigned*)(WR + (size_t)row * 1024 + half * 512 + mk_lane_id() * 8), (LAS unsigned*)(F.lds + RING_OFF + row * 2064 + half * 1024), 16, 0, 0); }
        VM_WAIT(); __syncthreads();
    }
    const LAS unsigned char* wl0 = (const LAS unsigned char*)(F.lds + RING_OFF);
    volatile LAS unsigned* hist = (volatile LAS unsigned*)(F.lds + TAB_OFF + 512); volatile LAS unsigned* base = (volatile LAS unsigned*)(F.lds + TAB_OFF + 768);
    const int lane = mk_lane_id(), i = lane & 15, g = lane >> 4;
    const int nrounds = (T / 16 + F.G * NWAVES - 1) / (F.G * NWAVES);
    for (int rd = 0; rd < nrounds; ++rd) {
        const int item = (rd * F.G + F.vcu) * NWAVES + F.wave; const bool live = item < T / 16; const int t0 = item * 16;
        if ((F.wave * 64 + mk_lane_id()) < 32) hist[(F.wave * 64 + mk_lane_id())] = 0u;
        __syncthreads();
        int te[4] = {0, 0, 0, 0}; float tg[4] = {0.f, 0.f, 0.f, 0.f}; float rt = 0.f; unsigned lr[4] = {0u, 0u, 0u, 0u};
        if (live) {
            pg8::f32x4 a0 = (pg8::f32x4){0.f, 0.f, 0.f, 0.f}, a1 = a0;
            const bf16_t* ap = H1 + (size_t)(t0 + i) * 1024 + 8 * g; const bf16_t* b0 = WR + (size_t)i * 1024 + 8 * g; const bf16_t* b1 = WR + (size_t)(16 + i) * 1024 + 8 * g;
            bf16x8_t avr[32];
#pragma unroll
            for (int ks = 0; ks < 32; ++ks) avr[ks] = *(const bf16x8_t*)(ap + 32 * ks);
            __builtin_amdgcn_sched_barrier(0);
#pragma unroll
            for (int ks = 0; ks < 32; ++ks) { const bf16x8_t bv0 = *(const LAS bf16x8_t*)(wl0 + i * 2064 + (8 * g + 32 * ks) * 2), bv1 = *(const LAS bf16x8_t*)(wl0 + (16 + i) * 2064 + (8 * g + 32 * ks) * 2);
                a0 = __builtin_amdgcn_mfma_f32_16x16x32_bf16(avr[ks], bv0, a0, 0, 0, 0); a1 = __builtin_amdgcn_mfma_f32_16x16x32_bf16(avr[ks], bv1, a1, 0, 0, 0); }
#pragma unroll
            for (int r = 0; r < 4; ++r) { lg[(4 * g + r) * 33 + i] = a0[r]; lg[(4 * g + r) * 33 + 16 + i] = a1[r]; }
            LDS_WAIT(); asm volatile("" ::: "memory");
            if (lane < 16) {
                const int t = t0 + lane; float ss = 0.f;
#pragma unroll
                for (int q = 0; q < 4; ++q) { const f32x4 v = *(const f32x4*)(SSQ + (size_t)t * 16 + 4 * q); ss += (v.x + v.y) + (v.z + v.w); }
                rt = 1.0f / sqrtf(ss * (1.0f / 1024.0f) + EPS);
                { float sp = 0.f;
#pragma unroll
                  for (int q = 0; q < 4; ++q) { const f32x4 v = *(const f32x4*)(SSQP + (size_t)t * 16 + 4 * q); sp += (v.x + v.y) + (v.z + v.w); }
                  RPLE[t] = 1.0f / sqrtf(sp * (1.0f / 1024.0f) + EPS); }
                float v[32];
#pragma unroll
                for (int e = 0; e < 32; ++e) v[e] = lg[lane * 33 + e] * rt + INP(10)[e];
                unsigned used = 0u; float tv[4];
#pragma unroll
                for (int j = 0; j < 4; ++j) { float best = -INFINITY; int bi = 0;
#pragma unroll
                    for (int e = 0; e < 32; ++e) { const bool ok = !((used >> e) & 1u) && v[e] > best; best = ok ? v[e] : best; bi = ok ? e : bi; }
                    used |= 1u << bi; tv[j] = best; te[j] = bi; }
                const float e1 = __expf(tv[1] - tv[0]), e2 = __expf(tv[2] - tv[0]), e3 = __expf(tv[3] - tv[0]), inv = 1.0f / (1.0f + e1 + e2 + e3);
                tg[0] = inv; tg[1] = e1 * inv; tg[2] = e2 * inv; tg[3] = e3 * inv;
#pragma unroll
                for (int j = 0; j < 4; ++j) lr[j] = __hip_atomic_fetch_add((LAS unsigned*)&hist[te[j]], 1u, __ATOMIC_RELAXED, __HIP_MEMORY_SCOPE_WORKGROUP);
            }
        }
        __syncthreads();
        if ((F.wave * 64 + mk_lane_id()) < 32) { const unsigned h = hist[(F.wave * 64 + mk_lane_id())]; base[(F.wave * 64 + mk_lane_id())] = h ? __hip_atomic_fetch_add(CNT + 64 * (F.wave * 64 + mk_lane_id()), h, __ATOMIC_RELAXED, __HIP_MEMORY_SCOPE_AGENT) : 0u; }
        __syncthreads();
        if (live && lane < 16) { const int t = t0 + lane;
#pragma unroll
            for (int j = 0; j < 4; ++j) { const unsigned pos = base[te[j]] + lr[j]; const size_t li = (size_t)te[j] * T + pos;
                LIST[li] = t; RLIST[li] = rt; GLIST[li] = tg[j]; TOPE[t * 4 + j] = te[j]; TPOS[t * 4 + j] = (int)pos; } }
        __syncthreads();
    }
}
__device__ __forceinline__ void moe_tables(Frame& F) {
    volatile LAS int* tb = (volatile LAS int*)(F.lds + TAB_OFF); volatile LAS int* cn = (volatile LAS int*)(F.lds + TAB_OFF + 256);
    if ((F.wave * 64 + mk_lane_id()) < 32) cn[(F.wave * 64 + mk_lane_id())] = (int)__hip_atomic_load((unsigned*)(F.ctl + CW_CNT) + 64 * (F.wave * 64 + mk_lane_id()), __ATOMIC_RELAXED, __HIP_MEMORY_SCOPE_AGENT);
    __syncthreads();
    if ((F.wave * 64 + mk_lane_id()) == 0) { int acc = 0; for (int e = 0; e < 32; ++e) { tb[e] = acc; acc += (cn[e] + 255) >> 8; } tb[32] = acc; }
    __syncthreads();
}
struct MoeOrder {
    const LAS int* tb; const LAS int* cn; int NT, G, c; bool rev = false;
    __device__ __forceinline__ bool next(int i, Unit& u) const {
        const int L = i * G + c, lane = mk_lane_id(); int mtg = L / NT; const int pn = L - mtg * NT;
        const int tq = tb[lane < 32 ? lane : 32]; const int tot = __builtin_amdgcn_readlane(tq, 32);
        if (mtg >= tot) return false;
        if (rev) mtg = tot - 1 - mtg;
        const int e = (int)__popcll(__ballot(lane < 32 && mtg >= tq)) - 1;
        const int tbe = __builtin_amdgcn_readlane(tq, e), cne = __builtin_amdgcn_readfirstlane(cn[e]);
        u.pm = mtg; u.pn = pn; u.e = e; u.ml = mtg - tbe; u.nrows = min(256, cne - u.ml * 256); return true; }
};
typedef float f32x2_t __attribute__((ext_vector_type(2)));
__device__ __forceinline__ f32x2_t swiglu2(f32x2_t glu, f32x2_t lin) {
    f32x2_t g, l; g.x = fminf(glu.x, 7.0f); g.y = fminf(glu.y, 7.0f); l.x = __builtin_amdgcn_fmed3f(lin.x, -7.0f, 7.0f); l.y = __builtin_amdgcn_fmed3f(lin.y, -7.0f, 7.0f);
    const f32x2_t t = g * (-1.702f * 1.4426950408889634f);
    f32x2_t e; e.x = __builtin_amdgcn_exp2f(t.x); e.y = __builtin_amdgcn_exp2f(t.y);
    const f32x2_t d = e + 1.0f;
    f32x2_t r; r.x = __builtin_amdgcn_rcpf(d.x); r.y = __builtin_amdgcn_rcpf(d.y);
    const f32x2_t f = g * l + g;
    return r * f;
}
__device__ __forceinline__ float swiglu_f(float a, float b) { const float gl = fminf(a, 7.0f), ln = fminf(fmaxf(b, -7.0f), 7.0f); return gl * fast_sigm(1.702f * gl) * (ln + 1.0f); }
struct Moe1Prob {
    static constexpr bool LIST_DMA = true, PERM64 = true, EPI_DMA = true, PERM = true, F8 = true, GATHER = true; static constexpr int SCALE_A = 0x7C7C7C7C, SCALE_B = 0x7C7C7C7C;
    static constexpr int K = 512; const unsigned char* A; const unsigned char* Bt; MoeOrder ord; const int* LIST; const float* RLIST; const float* b1; unsigned char* HID; PG8_LAS unsigned char* ldsbase;
    __device__ __forceinline__ void epi_dma(const Unit& u, PG8_LAS unsigned char* lds, const int wid, const int lane) const {
        const float* src = (wid < 4) ? (RLIST + (size_t)u.e * T + u.ml * 256 + wid * 64 + lane) : (b1 + (size_t)u.e * 2048 + u.pn * 256 + (wid - 4) * 64 + lane);
        __builtin_amdgcn_global_load_lds((const unsigned*)src, (PG8_LAS unsigned*)(lds + pg8::STAGE_BYTES + 10240 + wid * 256), 4, 0, 0); }
    __device__ __forceinline__ bool next(int i, Unit& u) const { return ord.next(i, u); }
    __device__ __forceinline__ const char* a_base(const Unit&) const { return (const char*)A; }
    __device__ __forceinline__ void a_offs(const Unit& u, int tid, unsigned (&o)[2][2]) const {
#pragma unroll
        for (int i = 0; i < 2; ++i) { int R, C; pg8::stage_rc(tid * 16 + i * 8192, R, C);
#pragma unroll
            for (int h = 0; h < 2; ++h) { const int lr = min(h * 128 + R, u.nrows - 1); const int tok = LIST[(size_t)u.e * T + u.ml * 256 + lr]; o[h][i] = (unsigned)(tok * K + C) * 2u; } } }
    __device__ __forceinline__ const char* b_base(const Unit& u) const { return (const char*)Bt + ((size_t)u.e * 2048 + (size_t)u.pn * 256) * K * 2; }
    __device__ __forceinline__ void a_offs_dma(const Unit& u, PG8_LAS unsigned char* lds, const int wid, const int lane) const {
#pragma unroll
        for (int i = 0; i < 2; ++i) { int R, C; pg8::stage_rc((wid * 64 + lane) * 16 + i * 8192, R, C);
#pragma unroll
            for (int h = 0; h < 2; ++h) { const int lr = min(h * 128 + R, u.nrows - 1);
                __builtin_amdgcn_global_load_lds((const unsigned*)(LIST + (size_t)u.e * T + u.ml * 256 + lr), (PG8_LAS unsigned*)(lds + pg8::STAGE_BYTES + 2048 + ((h * 2 + i) * 8 + wid) * 256), 4, 0, 0); } } }
    __device__ __forceinline__ void a_offs_ld(PG8_LAS unsigned char* lds, const int wid, const int lane, unsigned (&o)[2][2]) const {
#pragma unroll
        for (int i = 0; i < 2; ++i) { int R, C; pg8::stage_rc((wid * 64 + lane) * 16 + i * 8192, R, C);
#pragma unroll
            for (int h = 0; h < 2; ++h) { const int tok = *(const PG8_LAS int*)(lds + pg8::STAGE_BYTES + 2048 + ((h * 2 + i) * 8 + wid) * 256 + lane * 4); o[h][i] = (unsigned)(tok * K + C) * 2u; } } }
    __device__ __forceinline__ void epilogue(const pg8::f32x4 (&acc)[2][2][4][2], const Unit& u, int wr, int wc, int fr, int fq) const {
        int lr0 = wr * 64 + fr; asm volatile("" : "+v"(lr0));
        const int cw = u.pn * 256 + wc * 64 + 16 * fq;
        const PG8_LAS float* rl = (const PG8_LAS float*)(ldsbase + pg8::STAGE_BYTES + 10240); const PG8_LAS float* bb = rl + 256 + wc * 64 + 16 * fq;
        pg8::f32x4 bv[2][2];
#pragma unroll
        for (int bj = 0; bj < 2; ++bj) { bv[bj][0] = *(const PG8_LAS pg8::f32x4*)(bb + bj * 8); bv[bj][1] = *(const PG8_LAS pg8::f32x4*)(bb + bj * 8 + 4); }
        const int odd = fq & 1;
#pragma unroll
        for (int ai = 0; ai < 2; ++ai)
#pragma unroll
            for (int mp = 0; mp < 2; ++mp) { pg8::u32x2 w2[2];
#pragma unroll
                for (int q = 0; q < 2; ++q) { const int m = 2 * mp + q; const float rs = rl[lr0 + ai * 128 + m * 16];
#pragma unroll
                    for (int bj = 0; bj < 2; ++bj) { const pg8::f32x4 v0 = acc[ai][bj][m][0] * rs + bv[bj][0], v1 = acc[ai][bj][m][1] * rs + bv[bj][1];
                        const f32x2_t s0 = swiglu2((f32x2_t){v0[0], v0[2]}, (f32x2_t){v0[1], v0[3]}), s1 = swiglu2((f32x2_t){v1[0], v1[2]}, (f32x2_t){v1[1], v1[3]});
                        w2[q][bj] = pg8::pk4_fp8(s0.x, s0.y, s1.x, s1.y); } }
                { auto r0 = __builtin_amdgcn_permlane16_swap(w2[0].x, w2[1].x, false, false); w2[0].x = r0[0]; w2[1].x = r0[1];
                  auto r1 = __builtin_amdgcn_permlane16_swap(w2[0].y, w2[1].y, false, false); w2[0].y = r1[0]; w2[1].y = r1[1]; }
                const int lr = lr0 + ai * 128 + (2 * mp + odd) * 16;
                if (lr < u.nrows) *(pg8::u32x4*)(HID + ((unsigned)(u.pm * 256 + lr) * 1024u + (unsigned)((cw >> 1) - 8 * odd))) = (pg8::u32x4){w2[0].x, w2[0].y, w2[1].x, w2[1].y}; }
    }
};
struct Moe2Prob {
    static constexpr bool LIST_DMA = false, PERM64 = true, EPI_DMA = true, PERM = true, F8 = MOE2_F8, GATHER = true;     static constexpr int SCALE_A = 0x7C7C7C7C, SCALE_B = 0x7C7C7C7C;
    static constexpr int K = 512; const unsigned char* A; const unsigned char* Bt; MoeOrder ord; const float* GLIST; const float* b2; unsigned char* Y; PG8_LAS unsigned char* ldsbase;
    __device__ __forceinline__ bool next(int i, Unit& u) const { return ord.next(i, u); }
    __device__ __forceinline__ const char* a_base(const Unit&) const { return (const char*)A; }
    __device__ __forceinline__ void a_offs(const Unit& u, int tid, unsigned (&o)[2][2]) const {
#pragma unroll
        for (int i = 0; i < 2; ++i) { int R, C; pg8::stage_rc(tid * 16 + i * 8192, R, C);
#pragma unroll
            for (int h = 0; h < 2; ++h) o[h][i] = (unsigned)((u.pm * 256 + h * 128 + R) * K + C) * 2u; } }
    __device__ __forceinline__ const char* b_base(const Unit& u) const { return (const char*)Bt + ((size_t)u.e * 1024 + (size_t)u.pn * 256) * K * 2; }
    __device__ __forceinline__ void epi_dma(const Unit& u, PG8_LAS unsigned char* lds, const int wid, const int lane) const {
        const float* src = (wid < 4) ? (GLIST + (size_t)u.e * T + u.ml * 256 + wid * 64 + lane) : (b2 + (size_t)u.e * 1024 + u.pn * 256 + (wid - 4) * 64 + lane);
        __builtin_amdgcn_global_load_lds((const unsigned*)src, (PG8_LAS unsigned*)(lds + pg8::STAGE_BYTES + 10240 + wid * 256), 4, 0, 0); }
    __device__ __forceinline__ void epilogue(const pg8::f32x4 (&acc)[2][2][4][2], const Unit& u, int wr, int wc, int fr, int fq) const {
        int lr0 = wr * 64 + fr; asm volatile("" : "+v"(lr0));
        const int cw = u.pn * 256 + wc * 64 + 16 * fq;
        const PG8_LAS float* gl = (const PG8_LAS float*)(ldsbase + pg8::STAGE_BYTES + 10240); const PG8_LAS float* bb = gl + 256 + wc * 64 + 16 * fq;
        pg8::f32x4 bv[2][2];
#pragma unroll
        for (int bj = 0; bj < 2; ++bj) { bv[bj][0] = *(const PG8_LAS pg8::f32x4*)(bb + bj * 8); bv[bj][1] = *(const PG8_LAS pg8::f32x4*)(bb + bj * 8 + 4); }
#pragma unroll
        for (int ai = 0; ai < 2; ++ai)
#pragma unroll
            for (int m = 0; m < 4; ++m) { const int lr = lr0 + ai * 128 + m * 16; { const float gt = gl[lr] * 16.0f; unsigned char* rowp = Y + ((unsigned)(u.pm * 256 + lr) * 1024u + (unsigned)cw);
                pg8::u32x4 w8;
#pragma unroll
                for (int bj = 0; bj < 2; ++bj) { const pg8::f32x4 v0 = (acc[ai][bj][m][0] + bv[bj][0]) * gt, v1 = (acc[ai][bj][m][1] + bv[bj][1]) * gt;
                    w8[2 * bj] = pg8::pk4_fp8(v0[0], v0[1], v0[2], v0[3]); w8[2 * bj + 1] = pg8::pk4_fp8(v1[0], v1[1], v1[2], v1[3]); }
                *(pg8::u32x4*)rowp = w8; } }
    }
};
__device__ __forceinline__ void combine_phase(Frame& F) {
    const volatile LAS int* tb = (const volatile LAS int*)(F.lds + TAB_OFF);
    const bf16_t* H = (const bf16_t*)(F.ws + WS_H1); bf16_t* H2o = (bf16_t*)(F.ws + WS_H2); unsigned char* H8 = F.ws + WS_H2F8; const unsigned char* Y = F.ws + WS_Y; const int* TOPE = (const int*)(F.ws + WS_TOPE); const int* TPOS = (const int*)(F.ws + WS_TPOS);
    const int gw = F.vcu * NWAVES + F.wave, NGW = F.G * NWAVES, lane = mk_lane_id();
    typedef float f2v __attribute__((ext_vector_type(2)));
#pragma unroll 4
    for (int t = gw; t < T; t += NGW) {
        float a[16], ys[16];
        { const v4u h0 = __builtin_nontemporal_load((const v4u*)(H + (size_t)t * 1024 + lane * 16)), h1 = __builtin_nontemporal_load((const v4u*)(H + (size_t)t * 1024 + lane * 16 + 8));
          const unsigned hw[8] = {h0.x, h0.y, h0.z, h0.w, h1.x, h1.y, h1.z, h1.w};
#pragma unroll
          for (int q = 0; q < 8; ++q) { a[2 * q] = __uint_as_float(hw[q] << 16); a[2 * q + 1] = __uint_as_float(hw[q] & 0xffff0000u); } }
#pragma unroll
        for (int q = 0; q < 16; ++q) ys[q] = 0.f;
#pragma unroll
        for (int j = 0; j < 4; ++j) { const int e = TOPE[t * 4 + j], pos = TPOS[t * 4 + j]; const size_t row = (size_t)tb[e] * 256 + pos;
            const v4u y = __builtin_nontemporal_load((const v4u*)(Y + row * 1024 + lane * 16)); const unsigned yw[4] = {y.x, y.y, y.z, y.w};
#pragma unroll
            for (int q = 0; q < 4; ++q) { const f2v lo = __builtin_amdgcn_cvt_pk_f32_fp8((int)yw[q], false), hi = __builtin_amdgcn_cvt_pk_f32_fp8((int)yw[q], true);
                ys[4 * q] += lo[0]; ys[4 * q + 1] += lo[1]; ys[4 * q + 2] += hi[0]; ys[4 * q + 3] += hi[1]; } }
#pragma unroll
        for (int q = 0; q < 16; ++q) a[q] = __builtin_fmaf(ys[q], 0.0625f, a[q]);
        v4u o0, o1; o0.x = pk2(a[0], a[1]); o0.y = pk2(a[2], a[3]); o0.z = pk2(a[4], a[5]); o0.w = pk2(a[6], a[7]); o1.x = pk2(a[8], a[9]); o1.y = pk2(a[10], a[11]); o1.z = pk2(a[12], a[13]); o1.w = pk2(a[14], a[15]);
        *(v4u*)(H2o + (size_t)t * 1024 + lane * 16) = o0; *(v4u*)(H2o + (size_t)t * 1024 + lane * 16 + 8) = o1;
        v4u o8; o8.x = pg8::pk4_fp8(a[0], a[1], a[2], a[3]); o8.y = pg8::pk4_fp8(a[4], a[5], a[6], a[7]); o8.z = pg8::pk4_fp8(a[8], a[9], a[10], a[11]); o8.w = pg8::pk4_fp8(a[12], a[13], a[14], a[15]);
        *(v4u*)(H8 + (size_t)t * 1024 + lane * 16) = o8;
    }
}

struct GateProb {
    static constexpr bool LIST_DMA = false, PERM64 = true, EPI_DMA = false, PERM = true, F8 = true, GATHER = true; static constexpr int SCALE_A = 0x7C7C7C7C, SCALE_B = 0x7C7C7C7C;
    static constexpr int K = 512; const unsigned char* A; const unsigned char* Bt; const bf16_t* H2; pg8::StaticOrder ord; const bf16_t* PPRE; const float* RPLE; const float* g_ple; bf16_t* H3; float* SSQ;
    __device__ __forceinline__ bool next(int i, Unit& u) const { if (!ord.next(i, u)) return false; u.pm = ord.nM - 1 - u.pm; return true; }
    __device__ __forceinline__ const char* a_base(const Unit&) const { return (const char*)A; }
    __device__ __forceinline__ void a_offs(const Unit& u, int tid, unsigned (&o)[2][2]) const {
#pragma unroll
        for (int i = 0; i < 2; ++i) { int R, C; pg8::stage_rc(tid * 16 + i * 8192, R, C);
#pragma unroll
            for (int h = 0; h < 2; ++h) o[h][i] = (unsigned)((u.pm * 256 + h * 128 + R) * K + C) * 2u; } }
    __device__ __forceinline__ const char* b_base(const Unit& u) const { return (const char*)Bt + (size_t)u.pn * 256 * K * 2; }
    __device__ __forceinline__ void epilogue(const pg8::f32x4 (&acc)[2][2][4][2], const Unit& u, int wr, int wc, int fr, int fq) const {
        int row0 = u.pm * 256 + wr * 64 + fr; asm volatile("" : "+v"(row0));
        const int cw = u.pn * 256 + wc * 64 + 16 * fq;
        pg8::f32x4 gv[2][2];
#pragma unroll
        for (int bj = 0; bj < 2; ++bj) { gv[bj][0] = *(const pg8::f32x4*)(g_ple + cw + bj * 8); gv[bj][1] = *(const pg8::f32x4*)(g_ple + cw + bj * 8 + 4); }
#pragma unroll
        for (int ai = 0; ai < 2; ++ai) { float ssel = 0.f;
#pragma unroll
            for (int m = 0; m < 4; ++m) { const int row = row0 + ai * 128 + m * 16; const unsigned off = ((unsigned)row * 1024u + (unsigned)cw) * 2u; const float rp = RPLE[row] * 0.0625f; float ss = 0.f; pg8::u32x4 w[2];
                const pg8::u32x4 p8 = *(const pg8::u32x4*)((const unsigned char*)PPRE + (size_t)row * 1024 + cw);
#pragma unroll
                for (int bj = 0; bj < 2; ++bj) {
                    const pg8::u32x4 hw = *(const pg8::u32x4*)((const char*)H2 + off + bj * 16);
                    typedef float f2v_ __attribute__((ext_vector_type(2)));
                    const f2v_ pa = __builtin_amdgcn_cvt_pk_f32_fp8((int)p8[2 * bj], false), pb = __builtin_amdgcn_cvt_pk_f32_fp8((int)p8[2 * bj], true), pc = __builtin_amdgcn_cvt_pk_f32_fp8((int)p8[2 * bj + 1], false), pd = __builtin_amdgcn_cvt_pk_f32_fp8((int)p8[2 * bj + 1], true);
                    const float pv[8] = {pa[0], pa[1], pb[0], pb[1], pc[0], pc[1], pd[0], pd[1]};
                    pg8::f32x4 v0, v1;
#pragma unroll
                    for (int q = 0; q < 2; ++q) { const float h_lo = __uint_as_float(hw[q] << 16), h_hi = __uint_as_float(hw[q] & 0xffff0000u), p_lo = pv[2 * q], p_hi = pv[2 * q + 1];
                        v0[2 * q] = h_lo + fast_sigm(acc[ai][bj][m][0][2 * q]) * (p_lo * rp * gv[bj][0][2 * q]); v0[2 * q + 1] = h_hi + fast_sigm(acc[ai][bj][m][0][2 * q + 1]) * (p_hi * rp * gv[bj][0][2 * q + 1]); }
#pragma unroll
                    for (int q = 0; q < 2; ++q) { const float h_lo = __uint_as_float(hw[2 + q] << 16), h_hi = __uint_as_float(hw[2 + q] & 0xffff0000u), p_lo = pv[4 + 2 * q], p_hi = pv[4 + 2 * q + 1];
                        v1[2 * q] = h_lo + fast_sigm(acc[ai][bj][m][1][2 * q]) * (p_lo * rp * gv[bj][1][2 * q]); v1[2 * q + 1] = h_hi + fast_sigm(acc[ai][bj][m][1][2 * q + 1]) * (p_hi * rp * gv[bj][1][2 * q + 1]); }
                    ss += (v0[0] * v0[0] + v0[1] * v0[1]) + (v0[2] * v0[2] + v0[3] * v0[3]) + (v1[0] * v1[0] + v1[1] * v1[1]) + (v1[2] * v1[2] + v1[3] * v1[3]);
                    w[bj] = pg8::pack8(v0, v1); }
                pg8::st_rows16((bf16_t*)((char*)H3 + off) - (8 * (fr >> 3)) * 1024 + 8 * (fr >> 3), (size_t)8 * 1024, w[0], w[1], fr >= 8);
                ss += __shfl_xor(ss, 16); ss += __shfl_xor(ss, 32);
                ssel = (fq == m) ? ss : ssel; }
            SSQ[(size_t)(row0 + ai * 128 + fq * 16) * 16 + (u.pn & 3) * 4 + wc] = ssel; }
    }
};
__device__ __forceinline__ void final_phase(Frame& F) {
    const bf16_t* H3 = (const bf16_t*)(F.ws + WS_H3); const float* SSQ = (const float*)(F.ws + WS_SSQ_H3);
    const int gw = F.vcu * NWAVES + F.wave, NGW = F.G * NWAVES, lane = mk_lane_id();
#pragma unroll 2
    for (int t = gw; t < T; t += NGW) {
        const float sv = (lane < 16) ? SSQ[(size_t)t * 16 + lane] : 0.f; float ss = sv;
        ss += __shfl_xor(ss, 1); ss += __shfl_xor(ss, 2); ss += __shfl_xor(ss, 4); ss += __shfl_xor(ss, 8);
        ss = __shfl(ss, 0);
        const float r = 1.0f / sqrtf(ss * (1.0f / 1024.0f) + EPS);
#pragma unroll
        for (int hf = 0; hf < 2; ++hf) { const v4u h = __builtin_nontemporal_load((const v4u*)(H3 + (size_t)t * 1024 + hf * 512 + lane * 8)); const float* gp = INP(18) + hf * 512 + lane * 8; float* op = ((float*)mk_karg(F.kp, 152)) + (size_t)t * 1024 + hf * 512 + lane * 8;
            const f32x4 g0 = *(const f32x4*)gp, g1 = *(const f32x4*)(gp + 4);
            f32x4 o0, o1; o0.x = __uint_as_float(h.x << 16) * r * g0.x; o0.y = __uint_as_float(h.x & 0xffff0000u) * r * g0.y; o0.z = __uint_as_float(h.y << 16) * r * g0.z; o0.w = __uint_as_float(h.y & 0xffff0000u) * r * g0.w;
            o1.x = __uint_as_float(h.z << 16) * r * g1.x; o1.y = __uint_as_float(h.z & 0xffff0000u) * r * g1.y; o1.z = __uint_as_float(h.w << 16) * r * g1.z; o1.w = __uint_as_float(h.w & 0xffff0000u) * r * g1.w;
            __builtin_nontemporal_store(o0, (f32x4*)op); __builtin_nontemporal_store(o1, (f32x4*)(op + 4)); }
    }
}

struct Args { const float* in[19]; float* out; unsigned char* ws; int ph_lo, ph_hi, li, pad; };
__global__ void __launch_bounds__(NWAVES * 64, 2) mk_fwd(Args args) {
    extern __shared__ __attribute__((aligned(16))) unsigned char lds[];
    Frame F;
    F.lds = (LAS unsigned char*)lds; F.MISC = (volatile LAS unsigned*)(F.lds + MISC_OFF);
    F.wave = __builtin_amdgcn_readfirstlane((int)threadIdx.x >> 6);
    F.G = gridDim.x; { const int bx = blockIdx.x; F.vcu = (F.G % 8 == 0) ? (bx % 8) * (F.G / 8) + bx / 8 : bx; }
    F.ws = args.ws; F.ctl = (gu32*)(args.ws + WS_CTL); F.kp = (kptr_t)__builtin_amdgcn_kernarg_segment_ptr();
    for (int u = (int)threadIdx.x; u < (LDS_BYTES - LDSCTL_OFF) / 4; u += NWAVES * 64) ((LAS unsigned*)(F.lds + LDSCTL_OFF))[u] = 0u;
    __syncthreads();
    const int lo = args.ph_lo, hi = args.ph_hi;
    const bool multi = (hi - lo) > 1;
    XcdBarrier bar; bar.bar = (unsigned*)(F.ctl + CW_BAR) + args.li * XCD_BAR_WORDS; bar.x = 0; bar.st = nullptr;
    if (multi) bar = xcd_barrier_post((unsigned*)(F.ctl + CW_BAR) + args.li * XCD_BAR_WORDS, F.MISC + 8, F.wave == 0 && mk_lane_id() == 0);
#ifndef PH_MASK
#define PH_MASK 0xFFF
#endif
#define IN(k) (((PH_MASK >> (k)) & 1) && lo <= (k) && (k) < hi)
#define SEAM(k) do { if (IN(k) && IN((k) + 1)) xcd_barrier(bar, F.wave == 0 && mk_lane_id() == 0); } while (0)
    if (IN(0)) { p0_prologue(F, args.pad); SEAM(0); }
    if (IN(1)) {
        const int ple_first = ((int)blockIdx.x < 64) ? 2 : ((int)blockIdx.x < 128) ? 1 : 0;
        { PleProb P; P.A = F.ws + WS_PB; P.Bt = F.ws + WS_WPP; P.ord.init(T, 1024, F.G, (int)blockIdx.x);
          P.PPRE = (bf16_t*)(F.ws + WS_PPRE); P.SSQP = (float*)(F.ws + WS_SSQ_PLE); P.i0 = 0; P.n = ple_first;
          if (ple_first > 0) pg8::gemm_phase<PleProb>(F.lds + RING_OFF, P, F.wave); }
        { ProjProb P; P.A = (const bf16_t*)(F.ws + WS_XN); P.Bt = (const bf16_t*)(F.ws + WS_WIN); P.ord.init(T, NPROJ, F.G, (int)blockIdx.x);
          P.ws = F.ws; P.LA = (float*)(F.ws + WS_LA); P.KMEAN = (float*)(F.ws + WS_KMEAN); P.bgg = INP(5);
          if (!DBG_NOPROJ) pg8::gemm_phase<ProjProb>(F.lds + RING_OFF, P, F.wave); }
        { PleProb P; P.A = F.ws + WS_PB; P.Bt = F.ws + WS_WPP; P.ord.init(T, 1024, F.G, (int)blockIdx.x);
          P.PPRE = (bf16_t*)(F.ws + WS_PPRE); P.SSQP = (float*)(F.ws + WS_SSQ_PLE); P.i0 = ple_first; P.n = 4 - ple_first;
          if (!DBG_NOPLE) pg8::gemm_phase<PleProb>(F.lds + RING_OFF, P, F.wave); }
        SEAM(1);
    }
    const gla::lptr wl = (gla::lptr)(F.lds + RING_OFF + F.wave * 16384);
    const gla::lptr wsc = (gla::lptr)(F.lds + 133120 + F.wave * 1024);
    const int gw = F.vcu * NWAVES + F.wave, NGW = F.G * NWAVES;
    if (IN(2)) {
        const gla::Tensors GT{(const bf16_t*)(F.ws + WS_QG), (const bf16_t*)(F.ws + WS_KG), (const bf16_t*)(F.ws + WS_VG), (const bf16_t*)(F.ws + WS_RGS), (const bf16_t*)(F.ws + WS_LA),
                              (bf16_t*)(F.ws + WS_KVS), (float*)(F.ws + WS_DEC), INP(6), (bf16_t*)(F.ws + WS_MIX)};
        const attn_body::AttnTensors AT{(const char*)F.ws, (long)WS_QA, (long)WS_KA, (long)WS_VA, (long)WS_MIX, (long)WS_KMEAN};
        const attn_body::StaticOrder S((int)F.G, (int)blockIdx.x);
#ifndef DBG_NOATTN
        attn_body::attn_phase<attn_body::StaticOrder>((char*)lds + RING_OFF, AT, S, F.wave);
#endif
        __syncthreads();
#ifndef DBG_NOGLAA
        for (int u = gw; u < 2048; u += NGW) gla::unit_a(GT, u, wl, wsc, mk_lane_id());
#endif
        SEAM(2);
    }
    if (IN(3)) {
        const gla::Tensors GT{(const bf16_t*)(F.ws + WS_QG), (const bf16_t*)(F.ws + WS_KG), (const bf16_t*)(F.ws + WS_VG), (const bf16_t*)(F.ws + WS_RGS), (const bf16_t*)(F.ws + WS_LA),
                              (bf16_t*)(F.ws + WS_KVS), (float*)(F.ws + WS_DEC), INP(6), (bf16_t*)(F.ws + WS_MIX)};
        for (int it = gw; it < 1024; it += NGW) gla::scan_item(GT, it, mk_lane_id()); SEAM(3); }
    if (IN(4)) {
        const gla::Tensors GT{(const bf16_t*)(F.ws + WS_QG), (const bf16_t*)(F.ws + WS_KG), (const bf16_t*)(F.ws + WS_VG), (const bf16_t*)(F.ws + WS_RGS), (const bf16_t*)(F.ws + WS_LA),
                              (bf16_t*)(F.ws + WS_KVS), (float*)(F.ws + WS_DEC), INP(6), (bf16_t*)(F.ws + WS_MIX)};
        for (int u = gw; u < 2048; u += NGW) gla::unit_c(GT, u, wl, mk_lane_id()); SEAM(4); }
    if (IN(5)) {
        OutProb P; P.A = (const bf16_t*)(F.ws + WS_MIX); P.Bt = (const bf16_t*)(F.ws + WS_WOUT); P.ord.init(T, 1024, F.G, (int)blockIdx.x);
        P.X = INP(0); P.H1 = (bf16_t*)(F.ws + WS_H1); P.H1F8 = F.ws + WS_H1F8; P.SSQ = (float*)(F.ws + WS_SSQ_H1);
        pg8::gemm_phase<OutProb>(F.lds + RING_OFF, P, F.wave);
        SEAM(5);
    }
    if (IN(6)) { router_phase(F); SEAM(6); }
    if (IN(7)) {
        moe_tables(F);
        Moe1Prob P; P.A = F.ws + WS_H1F8; P.Bt = F.ws + WS_W1;
        P.ord.tb = (const LAS int*)(F.lds + TAB_OFF); P.ord.cn = (const LAS int*)(F.lds + TAB_OFF + 256); P.ord.NT = 8; P.ord.G = F.G; P.ord.c = F.vcu;
        P.LIST = (const int*)(F.ws + WS_LIST); P.RLIST = (const float*)(F.ws + WS_RLIST); P.b1 = INP(12); P.HID = F.ws + WS_HID; P.ldsbase = F.lds + RING_OFF;
        pg8::gemm_phase<Moe1Prob>(F.lds + RING_OFF, P, F.wave);
        SEAM(7);
    }
    if (IN(8)) {
        moe_tables(F);
        Moe2Prob P; P.A = F.ws + WS_HID; P.Bt = F.ws + WS_W2;
        P.ord.tb = (const LAS int*)(F.lds + TAB_OFF); P.ord.cn = (const LAS int*)(F.lds + TAB_OFF + 256); P.ord.NT = 4; P.ord.G = F.G; P.ord.c = F.vcu; P.ord.rev = true;
        P.GLIST = (const float*)(F.ws + WS_GLIST); P.b2 = INP(14); P.Y = F.ws + WS_Y; P.ldsbase = F.lds + RING_OFF;
        pg8::gemm_phase<Moe2Prob>(F.lds + RING_OFF, P, F.wave);
        SEAM(8);
    }
    if (IN(9)) { moe_tables(F); combine_phase(F); SEAM(9); }
    if (IN(10)) {
        GateProb P; P.A = F.ws + WS_H2F8; P.Bt = F.ws + WS_WPG; P.H2 = (const bf16_t*)(F.ws + WS_H2); P.ord.init(T, 1024, F.G, (int)blockIdx.x);
        P.PPRE = (const bf16_t*)(F.ws + WS_PPRE); P.RPLE = (const float*)(F.ws + WS_RPLE); P.g_ple = INP(17); P.H3 = (bf16_t*)(F.ws + WS_H3); P.SSQ = (float*)(F.ws + WS_SSQ_H3);
        pg8::gemm_phase<GateProb>(F.lds + RING_OFF, P, F.wave);
        SEAM(10);
    }
    if (IN(11)) { final_phase(F); }
#undef IN
#undef SEAM
}
}

extern "C" void kernel_launch(void* const* d_in, const int* in_sizes, int n_in, void* d_out, int out_size, void* d_ws, size_t ws_size, hipStream_t stream) {
    using namespace nv;
    const float* x = (const float*)d_in[0]; const float* p = (const float*)d_in[1]; const float* g_mix = (const float*)d_in[2]; const float* w_in = (const float*)d_in[3];
    const float* w_gg = (const float*)d_in[4]; const float* b_gg = (const float*)d_in[5]; const float* g_gn = (const float*)d_in[6]; const float* w_out = (const float*)d_in[7];
    const float* g_ffn = (const float*)d_in[8]; const float* w_router = (const float*)d_in[9]; const float* b_router = (const float*)d_in[10]; const float* w1 = (const float*)d_in[11];
    const float* b1 = (const float*)d_in[12]; const float* w2 = (const float*)d_in[13]; const float* b2 = (const float*)d_in[14]; const float* w_pg = (const float*)d_in[15];
    const float* w_pp = (const float*)d_in[16]; const float* g_ple = (const float*)d_in[17]; const float* g_final = (const float*)d_in[18];
    (void)x; (void)w_out; (void)g_gn; (void)p; (void)g_ffn; (void)w_pg; (void)g_ple; (void)g_final; (void)w_router; (void)b_router; (void)w1; (void)b1; (void)w2; (void)b2; (void)g_mix; (void)w_in; (void)w_gg; (void)b_gg; (void)w_pp; (void)in_sizes; (void)out_size;
    float* out = (float*)d_out;
    constexpr size_t MiB = 1u << 20;
    static int grid = 0;
    if (grid == 0) {
        if (ws_size < 1024 * MiB || n_in != 19) { fprintf(stderr, "kernel_launch: unexpected ws_size %zu / n_in %d\n", ws_size, n_in); grid = -1; return; }
        int dev = 0, cus = 0, per_cu = 0;
        if (hipGetDevice(&dev) != hipSuccess || hipDeviceGetAttribute(&cus, hipDeviceAttributeMultiprocessorCount, dev) != hipSuccess) { grid = -1; return; }
        if (hipFuncSetAttribute((const void*)mk::mk_fwd, hipFuncAttributeMaxDynamicSharedMemorySize, mk::LDS_BYTES) != hipSuccess) { fprintf(stderr, "kernel_launch: hipFuncSetAttribute failed\n"); grid = -1; return; }
        if (hipOccupancyMaxActiveBlocksPerMultiprocessor(&per_cu, (const void*)mk::mk_fwd, mk::NWAVES * 64, mk::LDS_BYTES) != hipSuccess || per_cu < 1) { fprintf(stderr, "kernel_launch: occupancy query says %d\n", per_cu); (void)hipGetLastError(); per_cu = 1; }
        grid = cus;
    }
    if (grid < 0) return;
    char* ws = (char*)d_ws;
    (void)hipMemsetAsync(ws + mk::WS_CTL, 0, mk::CTL_ZERO_BYTES, stream);
    mk::Args a{};
    for (int i = 0; i < 19; ++i) a.in[i] = (const float*)d_in[i];
    a.out = out; a.ws = (unsigned char*)d_ws;
    auto launch_phases = [&](int lo, int hi) { a.ph_lo = lo; a.ph_hi = hi; hipLaunchKernelGGL(mk::mk_fwd, dim3(grid), dim3(mk::NWAVES * 64), mk::LDS_BYTES, stream, a); };
    (void)launch_phases;
    auto coop = [&](int lo, int hi, int li) { a.ph_lo = lo; a.ph_hi = hi; a.li = li; void* kargs[] = {(void*)&a};
        const hipError_t le = hipLaunchCooperativeKernel((const void*)mk::mk_fwd, dim3(grid), dim3(mk::NWAVES * 64), kargs, mk::LDS_BYTES, stream);
        if (le != hipSuccess) fprintf(stderr, "kernel_launch: cooperative launch failed: %s (grid %d)\n", hipGetErrorString(le), grid); };
#if PROBE_REP_PHASE >= 0
    coop(0, PROBE_REP_PHASE + 1, 0); coop(PROBE_REP_PHASE, mk::NPHASES, 1);
#else
    coop(0, mk::NPHASES, 0);
#endif
}
```

```cpp
#include <hip/hip_runtime.h>
#include <cstdio>
#include <cstdint>

typedef unsigned short bf16_t;
__device__ __forceinline__ unsigned f2bf(float f) { unsigned u = __builtin_bit_cast(unsigned, f); return (u + 0x7fffu + ((u >> 16) & 1u)) >> 16; }
__device__ __forceinline__ float bf2f(bf16_t b) { return __uint_as_float(((unsigned)b) << 16); }

__device__ __forceinline__ int mk_lane_id() { return (int)__builtin_amdgcn_mbcnt_hi(~0u, __builtin_amdgcn_mbcnt_lo(~0u, 0u)); }
namespace nv {
constexpr int B = 8, S = 4096, D = 1024, T = B * S;
constexpr int HM = 8, NB = S / 256;
constexpr int HG = 4;
constexpr int PW = 3088;
constexpr int NE = 32;
constexpr float EPS = 1e-6f;
constexpr int C_QA = 0, C_KA = 512, C_VA = 1024, C_QG = 1536, C_KG = 1792, C_VG = 2048, C_RG = 2560, C_AG = 3072;

__device__ __forceinline__ float ldf(const float* p, size_t i) { return p[i]; }
__device__ __forceinline__ float ldf(const bf16_t* p, size_t i) { return bf2f(p[i]); }
__device__ __forceinline__ void stf(float* p, size_t i, float v) { p[i] = v; }
__device__ __forceinline__ void stf(bf16_t* p, size_t i, float v) { p[i] = (bf16_t)f2bf(v); }
__device__ __forceinline__ float4 ld4(const float* p) { return *(const float4*)p; }
__device__ __forceinline__ float4 ld4(const bf16_t* p) { const uint2 u = *(const uint2*)p; return make_float4(__uint_as_float(u.x << 16), __uint_as_float(u.x & 0xffff0000u), __uint_as_float(u.y << 16), __uint_as_float(u.y & 0xffff0000u)); }

template <class TI>
__global__ __launch_bounds__(256) void k_rmsnorm(const TI* __restrict__ x, const float* __restrict__ g, float* __restrict__ y, long long rows_, long long Dn_) {
    const int rows = (int)rows_, Dn = (int)Dn_;
    const int row = blockIdx.x * 4 + (threadIdx.x >> 6), lane = threadIdx.x & 63;
    if (row >= rows) return;
    const TI* xr = x + (size_t)row * Dn; float s = 0.f;
    for (int c = lane; c < Dn; c += 64) { const float v = ldf(xr, c); s += v * v; }
    for (int o = 32; o >= 1; o >>= 1) s += __shfl_xor(s, o);
    const float r = 1.0f / sqrtf(s / (float)Dn + EPS);
    for (int c = lane; c < Dn; c += 64) y[(size_t)row * Dn + c] = ldf(xr, c) * r * g[c];
}

struct TileInfo { int row0, nrows, e, base; };
template <class TA, class RM, class EP>
__global__ __launch_bounds__(256) void k_sgemm(const TA* __restrict__ A, const float* __restrict__ Bm, long long lda_, long long ldb_, long long K_, long long N_, RM rm, EP ep) {
    const int lda = (int)lda_, ldb = (int)ldb_, K = (int)K_, N = (int)N_;
    __shared__ float As[16][68]; __shared__ float Bs[16][68];
    TileInfo ti; if (!rm.tile((int)blockIdx.y, ti)) return;
    const float* Bp = Bm + rm.b_off(ti);
    const int tid = threadIdx.x, n0 = blockIdx.x * 64;
    const int ar = tid >> 2, ak = (tid & 3) * 4;
    const long asrc = (ar < ti.nrows) ? rm.src(ti, ar) : -1;
    const int bk = tid >> 4, bn = (tid & 15) * 4;
    const bool bok = (n0 + bn) < N;
    float acc[4][4];
#pragma unroll
    for (int i = 0; i < 4; ++i)
#pragma unroll
        for (int j = 0; j < 4; ++j) acc[i][j] = 0.f;
    const int ty = tid >> 4, tx = tid & 15;
    for (int k0 = 0; k0 < K; k0 += 16) {
        float4 av = make_float4(0.f, 0.f, 0.f, 0.f), bv = make_float4(0.f, 0.f, 0.f, 0.f);
        if (asrc >= 0) av = ld4(A + (size_t)asrc * lda + k0 + ak);
        if (bok) bv = *(const float4*)(Bp + (size_t)(k0 + bk) * ldb + n0 + bn);
        __syncthreads();
        As[ak + 0][ar] = av.x; As[ak + 1][ar] = av.y; As[ak + 2][ar] = av.z; As[ak + 3][ar] = av.w;
        *(float4*)&Bs[bk][bn] = bv;
        __syncthreads();
#pragma unroll
        for (int kk = 0; kk < 16; ++kk) {
            const float4 a4 = *(const float4*)&As[kk][ty * 4]; const float4 b4 = *(const float4*)&Bs[kk][tx * 4];
            const float a[4] = {a4.x, a4.y, a4.z, a4.w}, b[4] = {b4.x, b4.y, b4.z, b4.w};
#pragma unroll
            for (int i = 0; i < 4; ++i)
#pragma unroll
                for (int j = 0; j < 4; ++j) acc[i][j] += a[i] * b[j];
        }
    }
    const int c = n0 + tx * 4;
    if (c < N) {
#pragma unroll
        for (int i = 0; i < 4; ++i) { const int r = ty * 4 + i; if (r < ti.nrows) ep(ti, r, c, acc[i][0], acc[i][1], acc[i][2], acc[i][3]); }
    }
}
struct RMDense { long long M; __device__ bool tile(int mt, TileInfo& ti) const { ti.row0 = mt * 64; ti.nrows = 64; ti.e = 0; ti.base = 0; return ti.row0 < M; }
    __device__ long src(const TileInfo& ti, int r) const { return ti.row0 + r; } __device__ size_t b_off(const TileInfo&) const { return 0; } };
struct EpStore { float* C; long long ldc; __device__ void operator()(const TileInfo& ti, int r, int c, float v0, float v1, float v2, float v3) const { *(float4*)(C + (size_t)(ti.row0 + r) * ldc + c) = make_float4(v0, v1, v2, v3); } };
struct EpAddRes { const float* R; float* C; long long ldc; __device__ void operator()(const TileInfo& ti, int r, int c, float v0, float v1, float v2, float v3) const {
    const size_t o = (size_t)(ti.row0 + r) * ldc + c; const float4 x = *(const float4*)(R + o); *(float4*)(C + o) = make_float4(x.x + v0, x.y + v1, x.z + v2, x.w + v3); } };
struct EpBias { float* C; long long ldc; const float* bias; __device__ void operator()(const TileInfo& ti, int r, int c, float v0, float v1, float v2, float v3) const {
    *(float4*)(C + (size_t)(ti.row0 + r) * ldc + c) = make_float4(v0 + bias[c], v1 + bias[c + 1], v2 + bias[c + 2], v3 + bias[c + 3]); } };
__device__ __forceinline__ float sigm(float x) { return 1.0f / (1.0f + expf(-x)); }
struct EpPle { const float* h2; const float* ple; float* h3; __device__ void operator()(const TileInfo& ti, int r, int c, float v0, float v1, float v2, float v3) const {
    const size_t o = (size_t)(ti.row0 + r) * D + c; const float4 h = *(const float4*)(h2 + o), p = *(const float4*)(ple + o);
    *(float4*)(h3 + o) = make_float4(h.x + sigm(v0) * p.x, h.y + sigm(v1) * p.y, h.z + sigm(v2) * p.z, h.w + sigm(v3) * p.w); } };

struct RMMoe { const int* cnt; const int* list; long long gather;
    __device__ bool tile(int mt, TileInfo& ti) const { int tb = 0, rb = 0;
        for (int e = 0; e < NE; ++e) { const int c = cnt[e], nt = (c + 63) >> 6; if (mt < tb + nt) { ti.e = e; ti.row0 = (mt - tb) * 64; ti.nrows = min(64, c - ti.row0); ti.base = rb; return true; } tb += nt; rb += c; }
        return false; }
    __device__ long src(const TileInfo& ti, int r) const { return gather ? (long)list[(size_t)ti.e * T + ti.row0 + r] : (long)(ti.base + ti.row0 + r); }
    __device__ size_t b_off(const TileInfo& ti) const { return gather ? (size_t)ti.e * 1024 * 2048 : (size_t)ti.e * 1024 * 1024; } };
__device__ __forceinline__ float swiglu1(float a, float b) { const float g = fminf(a, 7.0f), l = fminf(fmaxf(b, -7.0f), 7.0f); return g * sigm(1.702f * g) * (l + 1.0f); }
struct EpSwiglu { float* act; const float* b1; __device__ void operator()(const TileInfo& ti, int r, int c, float v0, float v1, float v2, float v3) const {
    const float* bb = b1 + (size_t)ti.e * 2048 + c; float* o = act + (size_t)(ti.base + ti.row0 + r) * 1024 + (c >> 1);
    o[0] = swiglu1(v0 + bb[0], v1 + bb[1]); o[1] = swiglu1(v2 + bb[2], v3 + bb[3]); } };
struct EpMoeOut { float* h2; const float* b2; const int* list; const float* gate; long long slot; __device__ void operator()(const TileInfo& ti, int r, int c, float v0, float v1, float v2, float v3) const {
    const int tok = list[(size_t)ti.e * T + ti.row0 + r]; const float g = gate[tok * 4 + slot]; const float* bb = b2 + (size_t)ti.e * 1024 + c; float* o = h2 + (size_t)tok * D + c;
    o[0] += g * (v0 + bb[0]); o[1] += g * (v1 + bb[1]); o[2] += g * (v2 + bb[2]); o[3] += g * (v3 + bb[3]); } };

template <class TI>
__global__ __launch_bounds__(64) void k_kmean(const TI* __restrict__ k, long long ks, float* __restrict__ kmean) {
    const int n = blockIdx.x % NB, h = (blockIdx.x / NB) % HM, b = blockIdx.x / (NB * HM), d = threadIdx.x;
    float s = 0.f;
    for (int kk = 0; kk < 256; ++kk) s += ldf(k, ((size_t)b * S + n * 256 + kk) * ks + h * 64 + d);
    kmean[(size_t)blockIdx.x * 64 + d] = s * (1.0f / 256.0f);
}
template <class TI, class TO>
__global__ __launch_bounds__(64) void k_moba(const TI* __restrict__ qb, long long qs, const TI* __restrict__ kb, const TI* __restrict__ vb, long long ks, float qscale, float vpre, const float* __restrict__ kmean, TO* __restrict__ mix) {
    const int qc = blockIdx.x % (S / 64), h = (blockIdx.x / (S / 64)) % HM, b = blockIdx.x / ((S / 64) * HM);
    const int qpos = qc * 64 + threadIdx.x; const size_t t = (size_t)b * S + qpos;
    float q[64];
#pragma unroll
    for (int d = 0; d < 64; ++d) q[d] = ldf(qb, t * qs + h * 64 + d) * qscale;
    const int own = qpos >> 8;
    float g0 = -INFINITY, g1 = -INFINITY, g2 = -INFINITY; int i0 = -1, i1 = -1, i2 = -1;
    for (int n = 0; n < own; ++n) {
        const float* km = kmean + (((size_t)b * HM + h) * NB + n) * 64; float s = 0.f;
#pragma unroll
        for (int d = 0; d < 64; ++d) s += q[d] * km[d];
        if (s > g0) { g2 = g1; i2 = i1; g1 = g0; i1 = i0; g0 = s; i0 = n; }
        else if (s > g1) { g2 = g1; i2 = i1; g1 = s; i1 = n; }
        else if (s > g2) { g2 = s; i2 = n; }
    }
    const float slope = exp2f(-(float)(h + 1)); const float sl2 = slope * 1.4426950408889634f;
    float m = -INFINITY, l = 0.f; float o[64];
#pragma unroll
    for (int d = 0; d < 64; ++d) o[d] = 0.f;
    for (int j = 0; j < 4; ++j) {
        const int nblk = (j == 0) ? i0 : (j == 1) ? i1 : (j == 2) ? i2 : own;
        if (nblk < 0) continue;
        const int kend = (j < 3) ? 256 : (qpos - own * 256 + 1);
        for (int kk = 0; kk < kend; ++kk) {
            const int kpos = nblk * 256 + kk; const size_t ko = ((size_t)b * S + kpos) * ks + h * 64;
            float s = 0.f;
#pragma unroll
            for (int d = 0; d < 64; ++d) s += q[d] * ldf(kb, ko + d);
            s -= slope * (float)(qpos - kpos);
            const float mn = fmaxf(m, s), corr = expf(m - mn); float pe = expf(s - mn);
            l = l * corr + pe;
            if (vpre != 0.f) pe *= exp2f(-sl2 * (float)(kpos & 63));
#pragma unroll
            for (int d = 0; d < 64; ++d) o[d] = o[d] * corr + pe * ldf(vb, ko + d);
            m = mn;
        }
    }
    const float inv = 1.0f / l;
#pragma unroll
    for (int d = 0; d < 64; ++d) stf(mix, t * D + h * 64 + d, o[d] * inv);
}

__global__ __launch_bounds__(256) void k_gla_gate(const float* __restrict__ proj, const float* __restrict__ wg, const float* __restrict__ bg, float* __restrict__ la) {
    const size_t t = blockIdx.x; const int j = threadIdx.x;
    float z = bg[j];
#pragma unroll
    for (int r = 0; r < 16; ++r) z += proj[t * PW + C_AG + r] * wg[r * 256 + j];
    const float ls = fminf(z, 0.f) - log1pf(expf(-fabsf(z)));
    la[t * 256 + j] = ls * (1.0f / 16.0f);
}
template <class TI>
__global__ __launch_bounds__(128) void k_gla_rec(const TI* __restrict__ qb, const TI* __restrict__ kb, long long qs, const TI* __restrict__ vb, long long vs, const float* __restrict__ la, float* __restrict__ ogla) {
    const int b = blockIdx.x / HG, h = blockIdx.x % HG, dv = threadIdx.x;
    float s[64];
#pragma unroll
    for (int i = 0; i < 64; ++i) s[i] = 0.f;
    for (int t = 0; t < S; ++t) {
        const size_t row = (size_t)b * S + t; const float* ap = la + row * 256 + h * 64;
        const float v = ldf(vb, row * vs + h * 128 + dv); float o = 0.f;
#pragma unroll
        for (int i = 0; i < 64; ++i) { s[i] = expf(ap[i]) * s[i] + ldf(kb, row * qs + h * 64 + i) * v; o += ldf(qb, row * qs + h * 64 + i) * s[i]; }
        ogla[row * 512 + h * 128 + dv] = o * 0.125f;
    }
}
template <class TI, class TO>
__global__ __launch_bounds__(256) void k_gla_post(const float* __restrict__ ogla, const float* __restrict__ g, const TI* __restrict__ rg, long long rs, float rg_silu, TO* __restrict__ mix) {
    const int row = blockIdx.x * 4 + (threadIdx.x >> 6), lane = threadIdx.x & 63;
    const size_t t = row >> 2; const int h = row & 3;
    const float* xr = ogla + (size_t)row * 128; const float a = xr[lane], b = xr[lane + 64]; float s = a * a + b * b;
    for (int o = 32; o >= 1; o >>= 1) s += __shfl_xor(s, o);
    const float r = 1.0f / sqrtf(s / 128.0f + EPS);
    float r0 = ldf(rg, t * rs + h * 128 + lane), r1 = ldf(rg, t * rs + h * 128 + lane + 64);
    if (rg_silu == 0.f) { r0 = r0 * sigm(r0); r1 = r1 * sigm(r1); }
    stf(mix, t * D + 512 + h * 128 + lane, a * r * g[lane] * r0);
    stf(mix, t * D + 512 + h * 128 + lane + 64, b * r * g[lane + 64] * r1);
}

__global__ __launch_bounds__(256) void k_cvt_bf16_f32(const bf16_t* __restrict__ a, float* __restrict__ o, long long n) { for (long long i = (long long)blockIdx.x * 256 + threadIdx.x; i < n; i += (long long)gridDim.x * 256) o[i] = bf2f(a[i]); }
__global__ __launch_bounds__(256) void k_topk(const float* __restrict__ logits, int* __restrict__ tope, float* __restrict__ gate) {
    const int t = blockIdx.x * 256 + threadIdx.x; if (t >= T) return;
    float v[32];
#pragma unroll
    for (int e = 0; e < 32; ++e) v[e] = logits[(size_t)t * 32 + e];
    float tv[4]; int te[4]; unsigned used = 0u;
#pragma unroll
    for (int j = 0; j < 4; ++j) { float best = -INFINITY; int bi = 0;
#pragma unroll
        for (int e = 0; e < 32; ++e) { const bool ok = !((used >> e) & 1u) && v[e] > best; best = ok ? v[e] : best; bi = ok ? e : bi; }
        used |= 1u << bi; tv[j] = best; te[j] = bi; }
    const float e0 = 1.0f, e1 = expf(tv[1] - tv[0]), e2 = expf(tv[2] - tv[0]), e3 = expf(tv[3] - tv[0]); const float inv = 1.0f / (e0 + e1 + e2 + e3);
    tope[t * 4 + 0] = te[0]; tope[t * 4 + 1] = te[1]; tope[t * 4 + 2] = te[2]; tope[t * 4 + 3] = te[3];
    gate[t * 4 + 0] = e0 * inv; gate[t * 4 + 1] = e1 * inv; gate[t * 4 + 2] = e2 * inv; gate[t * 4 + 3] = e3 * inv;
}
__global__ __launch_bounds__(64) void k_sort_slot(const int* __restrict__ tope, long long slot_, int* __restrict__ list, int* __restrict__ cnt) {
    const int slot = (int)slot_;
    const int e = blockIdx.x, lane = threadIdx.x; int base = 0;
    for (int t0 = 0; t0 < T; t0 += 64) { const int t = t0 + lane; const bool hit = tope[t * 4 + slot] == e; const unsigned long long m = __ballot(hit);
        const int pos = base + __popcll(m & ((1ull << lane) - 1ull)); if (hit) list[(size_t)e * T + pos] = t; base += __popcll(m); }
    if (lane == 0) cnt[e] = base;
}
}

namespace pg8 {
#define PG8_LAS __attribute__((address_space(3)))
typedef short bf16x8 __attribute__((ext_vector_type(8)));
typedef float f32x4 __attribute__((ext_vector_type(4)));
typedef unsigned u32x4 __attribute__((ext_vector_type(4)));
typedef unsigned u32x2 __attribute__((ext_vector_type(2)));
constexpr int BM = 256, BK = 64, HALF = 128, HTB = HALF * BK * 2  , STAGE_BYTES = 8 * HTB, NXCD = 8, WGM = 8;

__host__ __device__ __forceinline__ int lds_byte(int r, int c) { const int st = (r >> 4) * 2 + (c >> 5), rr = r & 15, cc = c & 31, ob = rr * 64 + cc * 2; return st * 1024 + (ob ^ (((ob >> 9) & 1) << 5)); }
__host__ __device__ __forceinline__ void stage_rc(int b, int& R, int& C) { const int st = b / 1024, sb = b % 1024, swz = sb ^ (((sb >> 9) & 1) << 5); R = (st >> 1) * 16 + swz / 64; C = (st & 1) * 32 + (swz % 64) / 2; }
__host__ __device__ __forceinline__ int perm32(int rho) { const int n = rho >> 4, i = rho & 15; return 8 * (i >> 2) + 4 * n + (i & 3); }

struct Unit { int pm, pn, e, nrows, ml; };

struct StaticOrder {
    int nM, nN, nwg, G, c;
    __host__ __device__ __forceinline__ void init(int M, int N, int G_, int c_) { nM = M / BM; nN = N / BM; nwg = nM * nN; G = G_; c = c_; }
    __host__ __device__ __forceinline__ bool next(int i, Unit& u) const { return at((long)i * G + c, u); }
    __host__ __device__ __forceinline__ bool at(const long L, Unit& u) const {
        if (L >= nwg) return false;
        int wgid = (int)L; { const int q = nwg / NXCD, r = nwg % NXCD, xcd = wgid % NXCD, off = wgid / NXCD; wgid = (xcd < r ? xcd * (q + 1) : r * (q + 1) + (xcd - r) * q) + off; }
        const int nig = WGM * nN, gid = wgid / nig, fm = gid * WGM, gsz = (nM - fm) < WGM ? (nM - fm) : WGM;
        u.pm = fm + ((wgid % nig) % gsz); u.pn = (wgid % nig) / gsz; u.e = 0; u.nrows = 256; u.ml = 0; return true;
    }
};

typedef int v8i __attribute__((ext_vector_type(8)));
typedef int v4i __attribute__((ext_vector_type(4)));
__device__ __forceinline__ v8i cat8i(const bf16x8 a, const bf16x8 b) { const v4i x = __builtin_bit_cast(v4i, a), y = __builtin_bit_cast(v4i, b); return __builtin_shufflevector(x, y, 0, 1, 2, 3, 4, 5, 6, 7); }
__device__ __forceinline__ unsigned pk4_fp8(float a, float b, float c, float d) { int w = 0; w = __builtin_amdgcn_cvt_pk_fp8_f32(a, b, w, false); w = __builtin_amdgcn_cvt_pk_fp8_f32(c, d, w, true); return (unsigned)w; }
__device__ __forceinline__ unsigned cvt_pk_bf16(float lo, float hi) { unsigned r; asm volatile("v_cvt_pk_bf16_f32 %0, %1, %2" : "=v"(r) : "v"(lo), "v"(hi)); return r; }
__device__ __forceinline__ u32x4 pack8(const f32x4 v0, const f32x4 v1) { u32x4 w; w.x = cvt_pk_bf16(v0[0], v0[1]); w.y = cvt_pk_bf16(v0[2], v0[3]); w.z = cvt_pk_bf16(v1[0], v1[1]); w.w = cvt_pk_bf16(v1[2], v1[3]); return w; }

template <class E> __device__ __forceinline__ void st_rows16(E* p, const size_t ld8, const u32x4 w0, const u32x4 w1, const bool high) {
    u32x4 d1, d2;
#pragma unroll
    for (int q = 0; q < 4; ++q) { const unsigned x = high ? w0[q] : w1[q]; const unsigned y = (unsigned)__builtin_amdgcn_update_dpp(0, (int)x, 0x128, 0xf, 0xf, true); d1[q] = high ? y : w0[q]; d2[q] = high ? w1[q] : y; }
    *(u32x4*)p = d1; *(u32x4*)(p + ld8) = d2;
}
template <class P, bool ALIGN_EPI = true, bool SP2 = true>
__device__ __forceinline__ void gemm_phase(PG8_LAS unsigned char* lds, const P& pr, const int wid  ) {
    const int lane = mk_lane_id(), tid = wid * 64 + lane, wr = wid >> 2, wc = wid & 3, fr = lane & 15, fq = lane >> 4;
    constexpr int K = P::K, nt = K / BK;
    unsigned voffB[2];
#pragma unroll
    for (int i = 0; i < 2; ++i) { int R, C; stage_rc(tid * 16 + i * 8192, R, C); const int Rb = P::PERM64 ? ((R >> 5) * 64 + 2 * perm32(R & 31) - (perm32(R & 31) & 7)) : P::PERM ? ((R & ~31) + perm32(R & 31)) : R; voffB[i] = (unsigned)(Rb * K + C) * 2u; }
    const size_t kstep = (size_t)(BK * 2);
    const size_t hstep = (size_t)(P::PERM64 ? 8 : HALF) * K * 2;
    const unsigned ldsw = (unsigned)wid * 1024u;
    const int aoff = lds_byte(wr * 64 + fr, fq * 8), boff = lds_byte(wc * 32 + fr, fq * 8);
#define PG8_SA(b, h) (((b) * 2 + (h)) * HTB)
#define PG8_SB(b, h) ((4 + (b) * 2 + (h)) * HTB)
#define PG8_STAGE(bufoff, gbase, voff) do { _Pragma("unroll") for (int _i = 0; _i < 2; ++_i) \
        __builtin_amdgcn_global_load_lds((const unsigned*)((const char*)(gbase) + (voff)[_i]), (PG8_LAS unsigned*)(lds + (bufoff) + ldsw + _i * 8192), 16, 0, 0); } while (0)
#define PG8_LDA(dst, b, h) do { if constexpr (P::F8) { _Pragma("unroll") for (int m = 0; m < 4; ++m) dst##8[m] = cat8i(*(const PG8_LAS bf16x8*)(lds + PG8_SA(b, h) + aoff + m * 2048), *(const PG8_LAS bf16x8*)(lds + PG8_SA(b, h) + aoff + m * 2048 + 1024)); } \
        else { _Pragma("unroll") for (int m = 0; m < 4; ++m) _Pragma("unroll") for (int k = 0; k < 2; ++k) dst[m][k] = *(const PG8_LAS bf16x8*)(lds + PG8_SA(b, h) + aoff + m * 2048 + k * 1024); } } while (0)
#define PG8_LDB(dst, b, h) do { if constexpr (P::F8) { _Pragma("unroll") for (int n = 0; n < 2; ++n) dst##8[n] = cat8i(*(const PG8_LAS bf16x8*)(lds + PG8_SB(b, h) + boff + n * 2048), *(const PG8_LAS bf16x8*)(lds + PG8_SB(b, h) + boff + n * 2048 + 1024)); } \
        else { _Pragma("unroll") for (int n = 0; n < 2; ++n) _Pragma("unroll") for (int k = 0; k < 2; ++k) dst[n][k] = *(const PG8_LAS bf16x8*)(lds + PG8_SB(b, h) + boff + n * 2048 + k * 1024); } } while (0)
#define PG8_MMA(ai, bj, At, Bt) do { __builtin_amdgcn_s_setprio(1); \
        if constexpr (P::F8) { _Pragma("unroll") for (int m = 0; m < 4; ++m) _Pragma("unroll") for (int n = 0; n < 2; ++n) \
            acc[ai][bj][m][n] = __builtin_amdgcn_mfma_scale_f32_16x16x128_f8f6f4(Bt##8[n], At##8[m], acc[ai][bj][m][n], 0, 0, 0, P::SCALE_B, 0, P::SCALE_A); } \
        else { _Pragma("unroll") for (int m = 0; m < 4; ++m) _Pragma("unroll") for (int n = 0; n < 2; ++n) _Pragma("unroll") for (int k = 0; k < 2; ++k) \
            acc[ai][bj][m][n] = __builtin_amdgcn_mfma_f32_16x16x32_bf16(Bt[n][k], At[m][k], acc[ai][bj][m][n], 0, 0, 0); } \
        __builtin_amdgcn_s_setprio(0); } while (0)
#define PG8_WAIT_V(n) asm volatile("s_waitcnt vmcnt(" #n ")" ::: "memory")
#define PG8_WAIT_L(n) asm volatile("s_waitcnt lgkmcnt(" #n ")" ::: "memory")
#define PG8_BAR __builtin_amdgcn_s_barrier()
#define PG8_SCHED __builtin_amdgcn_sched_barrier(0)
    Unit cur, nxt; int ui = 0;
    if (!pr.next(0, cur)) return;
    f32x4 acc[2][2][4][2];
#pragma unroll
    for (int a = 0; a < 2; ++a)
#pragma unroll
        for (int b = 0; b < 2; ++b)
#pragma unroll
            for (int m = 0; m < 4; ++m)
#pragma unroll
                for (int n = 0; n < 2; ++n) acc[a][b][m][n] = (f32x4){0.f, 0.f, 0.f, 0.f};
    bf16x8 At[4][2], B0[2][2], B1[2][2]; v8i At8[4], B08[2], B18[2];
    unsigned oAc[2][2];
    PG8_LAS u32x4* const oslot = (PG8_LAS u32x4*)(lds + STAGE_BYTES + 2048) + tid;
    pr.a_offs(cur, tid, oAc);
    const char* cA = pr.a_base(cur); const char* cB = pr.b_base(cur);
    PG8_STAGE(PG8_SB(0, 0), cB, voffB); PG8_STAGE(PG8_SB(0, 1), cB + hstep, voffB); PG8_STAGE(PG8_SA(0, 0), cA, oAc[0]); PG8_STAGE(PG8_SA(0, 1), cA, oAc[1]);
    if (wr == 1) PG8_BAR;
    PG8_WAIT_V(2); PG8_BAR;
    PG8_STAGE(PG8_SB(1, 0), cB + kstep, voffB); PG8_STAGE(PG8_SA(1, 0), cA + kstep, oAc[0]); PG8_STAGE(PG8_SB(1, 1), cB + hstep + kstep, voffB);
    PG8_WAIT_V(6); PG8_BAR;
    for (;;) {
        const bool has_next = pr.next(ui + 1, nxt);
        const char* nA = cA; const char* nB = cB;
        if (has_next) { nA = pr.a_base(nxt); nB = pr.b_base(nxt);
            if constexpr (P::LIST_DMA) pr.a_offs_dma(nxt, lds, wid, lane);
            else if constexpr (P::GATHER) { unsigned on[2][2]; pr.a_offs(nxt, tid, on); *oslot = (u32x4){on[0][0], on[0][1], on[1][0], on[1][1]}; } }
#pragma unroll 1
        for (int t = 0; t < nt; t += 2) {
            const bool last = (t == nt - 2);
            const char* a1 = cA + (size_t)(t + 1) * kstep;
            const char* a2 = last ? nA : cA + (size_t)(t + 2) * kstep; const char* b2 = last ? nB : cB + (size_t)(t + 2) * kstep;
            const char* a3 = a2 + kstep; const char* b3 = b2 + kstep;
            if constexpr (P::EPI_DMA) { if (last) pr.epi_dma(cur, lds, wid, lane); }
            PG8_LDB(B0, 0, 0); PG8_LDB(B1, 0, 1); PG8_SCHED; PG8_LDA(At, 0, 0); PG8_STAGE(PG8_SA(1, 1), a1, oAc[1]);
            if constexpr (P::LIST_DMA) { if (last && has_next) pr.a_offs_ld(lds, wid, lane, oAc); }
            else if constexpr (P::GATHER) { if (last && has_next) {
                const u32x4 on = *oslot; oAc[0][0] = on[0]; oAc[0][1] = on[1]; oAc[1][0] = on[2]; oAc[1][1] = on[3]; } }
            PG8_WAIT_V(8); PG8_WAIT_L(0); PG8_BAR; PG8_MMA(0, 0, At, B0); PG8_MMA(0, 1, At, B1); PG8_BAR; PG8_SCHED;
            PG8_LDA(At, 0, 1); PG8_STAGE(PG8_SB(0, 0), b2, voffB); PG8_STAGE(PG8_SB(0, 1), b2 + hstep, voffB); PG8_STAGE(PG8_SA(0, 0), a2, oAc[0]);
            PG8_WAIT_V(8); PG8_WAIT_L(0); PG8_BAR; PG8_MMA(1, 0, At, B0); PG8_MMA(1, 1, At, B1); PG8_BAR; PG8_SCHED;
            PG8_LDB(B0, 1, 0); PG8_LDB(B1, 1, 1); PG8_SCHED; PG8_LDA(At, 1, 0); PG8_STAGE(PG8_SA(0, 1), a2, oAc[1]);
            PG8_WAIT_V(8); PG8_WAIT_L(0); PG8_BAR; PG8_MMA(0, 0, At, B0); PG8_MMA(0, 1, At, B1); PG8_BAR; PG8_SCHED;
            PG8_LDA(At, 1, 1); PG8_STAGE(PG8_SB(1, 0), b3, voffB); PG8_STAGE(PG8_SB(1, 1), b3 + hstep, voffB); PG8_STAGE(PG8_SA(1, 0), a3, oAc[0]);
            PG8_WAIT_V(8); PG8_WAIT_L(0); PG8_BAR; PG8_MMA(1, 0, At, B0); PG8_MMA(1, 1, At, B1); PG8_BAR; PG8_SCHED;
        }
        if constexpr (ALIGN_EPI) { if (wr == 0) PG8_BAR; }
        { int fr_ = fr, fq_ = fq; asm volatile("" : "+v"(fr_), "+v"(fq_));
          pr.epilogue(acc, cur, wr, wc, fr_, fq_); }
        if (!has_next) break;
#pragma unroll
        for (int a = 0; a < 2; ++a)
#pragma unroll
            for (int b = 0; b < 2; ++b)
#pragma unroll
                for (int m = 0; m < 4; ++m)
#pragma unroll
                    for (int n = 0; n < 2; ++n) acc[a][b][m][n] = (f32x4){0.f, 0.f, 0.f, 0.f};
        cur = nxt; cA = nA; cB = nB; ++ui;
        if constexpr (ALIGN_EPI) { if (wr == 1) PG8_BAR; }
    }
    PG8_WAIT_V(0);
    if constexpr (!ALIGN_EPI) { if (wr == 0) PG8_BAR; }
    PG8_BAR;
#undef PG8_SA
#undef PG8_SB
#undef PG8_STAGE
#undef PG8_LDA
#undef PG8_LDB
#undef PG8_MMA
#undef PG8_WAIT_V
#undef PG8_WAIT_L
#undef PG8_BAR
#undef PG8_SCHED
}
}
#include <hip/hip_bf16.h>
#include <cmath>
namespace attn_body {
using bf16=__hip_bfloat16;
using bf16x8=__attribute__((ext_vector_type(8)))short;
using s16x4=__attribute__((ext_vector_type(4)))short;
using f32x16=__attribute__((ext_vector_type(16)))float;
using u32x4=__attribute__((ext_vector_type(4)))unsigned;
constexpr int BATCH=8,NHEAD=8,SEQ=4096,D=64,DM=NHEAD*D,OPITCH=1024;
constexpr int NW=8,QBLK=32,QB=QBLK*NW,KVBLK=64,NQB=SEQ/QB;
constexpr int ATTN_PITCH=DM, ATTN_UNIT_ROWS=QB;
__device__ __forceinline__ int crow(int r,int hi){return (r&3)+8*(r>>2)+4*hi;}
#define SBAR() __builtin_amdgcn_sched_barrier(0)
__device__ __forceinline__ void cmask(f32x16&p0,f32x16&p1,int jb,int qrel,int hi){
  const float NEG=-INFINITY; int kb=64*jb+4*hi;
  #pragma unroll
  for(int r=0;r<16;++r){int kv=kb+(r&3)+8*(r>>2); if(kv>qrel)p0[r]=NEG; if(kv+32>qrel)p1[r]=NEG;}
}

constexpr int NSLOT=3, SLOTB=8192;
constexpr int LDS_K=0, LDS_V=NSLOT*SLOTB, LDS_WS=2*NSLOT*SLOTB, LDS_OST=LDS_WS+NW*64*4, LDS_BYTES=LDS_OST+NW*4096;
constexpr float C2=0.125f*1.4426950408889634f;
__device__ __forceinline__ void glds16(const void*gsrc,unsigned lds_dst){unsigned keep;
  asm volatile("s_mov_b32 %0, m0\n\ts_mov_b32 m0, %2\n\ts_nop 0\n\tglobal_load_lds_dwordx4 %1, off\n\ts_mov_b32 m0, %0":"=&s"(keep):"v"(gsrc),"s"(lds_dst):"memory");}
__device__ __forceinline__ float max3f(float a,float b,float c){float r;asm("v_max3_f32 %0, %1, %2, %3":"=v"(r):"v"(a),"v"(b),"v"(c));return r;}
__device__ __forceinline__ float max2f(float a,float b){float r;asm("v_max_f32_e32 %0, %1, %2":"=v"(r):"v"(a),"v"(b));return r;}
__device__ __forceinline__ float fadd_s(float a,float b){float r;asm("v_add_f32_e32 %0, %1, %2":"=v"(r):"v"(a),"v"(b));return r;}
__device__ __forceinline__ float fsub_s(float a,float b){float r;asm("v_sub_f32_e32 %0, %1, %2":"=v"(r):"v"(a),"v"(b));return r;}
typedef float f32x2_t __attribute__((ext_vector_type(2))); typedef __bf16 bf16x2_t __attribute__((ext_vector_type(2)));
__device__ __forceinline__ unsigned cvtpk_s(float lo,float hi){f32x2_t v={lo,hi};bf16x2_t b=__builtin_convertvector(v,bf16x2_t);return __builtin_bit_cast(unsigned,b);}
#define WAIT_BAR(N) asm volatile("s_waitcnt vmcnt(" #N ") lgkmcnt(0)\n\ts_barrier":::"memory")

__device__ __forceinline__ void qkt(f32x16&p0,f32x16&p1,const char*Kslot,const bf16x8*qr,const f32x16&negm,int r32,int hi){
  const char*kb=Kslot+hi*1024+r32*16;
  #pragma unroll
  for(int d0=0;d0<4;++d0){
    const bf16x8 b0=*reinterpret_cast<const bf16x8*>(kb+d0*2048);
    const bf16x8 b1=*reinterpret_cast<const bf16x8*>(kb+d0*2048+512);
    if(d0==0){p0=__builtin_amdgcn_mfma_f32_32x32x16_bf16(b0,qr[0],negm,0,0,0);p1=__builtin_amdgcn_mfma_f32_32x32x16_bf16(b1,qr[0],negm,0,0,0);}
    else{p0=__builtin_amdgcn_mfma_f32_32x32x16_bf16(b0,qr[d0],p0,0,0,0);p1=__builtin_amdgcn_mfma_f32_32x32x16_bf16(b1,qr[d0],p1,0,0,0);}}
}
typedef __attribute__((address_space(3))) const char* lds_cptr;
typedef short v4i16_t __attribute__((ext_vector_type(4)));
__device__ __forceinline__ void kload8(bf16x8*kf,lds_cptr kp){
  kf[0]=*(const __attribute__((address_space(3))) bf16x8*)(kp);      kf[1]=*(const __attribute__((address_space(3))) bf16x8*)(kp+512);
  kf[2]=*(const __attribute__((address_space(3))) bf16x8*)(kp+2048); kf[3]=*(const __attribute__((address_space(3))) bf16x8*)(kp+2560);
  kf[4]=*(const __attribute__((address_space(3))) bf16x8*)(kp+4096); kf[5]=*(const __attribute__((address_space(3))) bf16x8*)(kp+4608);
  kf[6]=*(const __attribute__((address_space(3))) bf16x8*)(kp+6144); kf[7]=*(const __attribute__((address_space(3))) bf16x8*)(kp+6656);
}
__device__ __forceinline__ void kload2(bf16x8*kf,lds_cptr kp,int j){ kf[2*j]=*(const __attribute__((address_space(3))) bf16x8*)(kp+j*2048); kf[2*j+1]=*(const __attribute__((address_space(3))) bf16x8*)(kp+j*2048+512); }
__device__ __forceinline__ s16x4 vtr(lds_cptr p){ return __builtin_bit_cast(s16x4,__builtin_amdgcn_ds_read_tr16_b64_v4i16((__attribute__((address_space(3))) v4i16_t*)p)); }
__device__ __forceinline__ float rowmax(const f32x16&p0,const f32x16&p1){
  float a=max3f(p0[0],p0[1],p1[0]),b=max3f(p0[2],p0[3],p1[1]);a=max3f(a,p1[2],p1[3]);
  #pragma unroll
  for(int r=4;r<16;r+=4){a=max3f(a,p0[r],p0[r+1]);b=max3f(b,p0[r+2],p0[r+3]);a=max3f(a,p1[r],p1[r+1]);b=max3f(b,p1[r+2],p1[r+3]);}
  const float m=max2f(a,b);
  auto rr=__builtin_amdgcn_permlane32_swap(__float_as_uint(m),__float_as_uint(m),false,false);
  return max2f(__uint_as_float(rr[0]),__uint_as_float(rr[1]));
}
__device__ __forceinline__ void pv(f32x16*o,int vb,bf16x8 pa0,bf16x8 pa1,bf16x8 pa2,bf16x8 pa3){
  #pragma unroll
  for(int d0=0;d0<2;++d0){s16x4 lo[4],hi[4];
    #pragma unroll
    for(int ks=0;ks<4;++ks){
      asm volatile("ds_read_b64_tr_b16 %0,%1 offset:%c2":"=&v"(lo[ks]):"v"(vb),"i"(d0*4096+ks*1024):"memory");
      asm volatile("ds_read_b64_tr_b16 %0,%1 offset:%c2":"=&v"(hi[ks]):"v"(vb),"i"(d0*4096+ks*1024+512):"memory");}
    asm volatile("s_waitcnt lgkmcnt(0)":::"memory");SBAR();
    #define PK(k) (bf16x8){lo[k][0],lo[k][1],lo[k][2],lo[k][3],hi[k][0],hi[k][1],hi[k][2],hi[k][3]}
    o[d0]=__builtin_amdgcn_mfma_f32_32x32x16_bf16(pa0,PK(0),o[d0],0,0,0);
    o[d0]=__builtin_amdgcn_mfma_f32_32x32x16_bf16(pa1,PK(1),o[d0],0,0,0);
    o[d0]=__builtin_amdgcn_mfma_f32_32x32x16_bf16(pa2,PK(2),o[d0],0,0,0);
    o[d0]=__builtin_amdgcn_mfma_f32_32x32x16_bf16(pa3,PK(3),o[d0],0,0,0);
    #undef PK
  }
}

#ifndef ATTN_STORE16
#define ATTN_STORE16(p,v) (*(u32x4*)(p)=(v))
#endif
template<int THRL> __device__ __forceinline__ void attn_unit(int b,int h,int qb,const bf16*Q,const bf16*__restrict__ K,const bf16*__restrict__ V,bf16*O,const float*__restrict__ KMEAN,char*shm,const int wid){
  const int lane=mk_lane_id(),r32=lane&31,hi=lane>>5;
  const long rowbase=(long)b*SEQ; const int q0=qb*QB;
  const bf16*Qw=Q+(rowbase+q0+wid*QBLK)*DM+h*D;
  const bf16*Kh=K+rowbase*DM+h*D,*Vh=V+rowbase*DM+h*D;
  const unsigned lds0=(unsigned)(uintptr_t)shm;
  float*wsf=(float*)(shm+LDS_WS)+wid*64;
  const bf16*ksrc=Kh+(long)lane*DM+wid*8;
  const bf16*vsrc=Vh+(long)(16*(wid&3)+(lane>>2))*DM+(wid>>2)*32+(lane&3)*8;
  const unsigned kdst=lds0+LDS_K+wid*1024, vdst=lds0+LDS_V+wid*1024;
  #define DMA_K(t,slot) glds16(ksrc+(long)(t)*KVBLK*DM,(unsigned)__builtin_amdgcn_readfirstlane(kdst+(slot)))
  #define DMA_V(t,slot) glds16(vsrc+(long)(t)*KVBLK*DM,(unsigned)__builtin_amdgcn_readfirstlane(vdst+(slot)))
  const int vb0=(int)(lds0+LDS_V)+((lane>>4)&1)*32+(lane&3)*8+(4*hi+((lane&15)>>2))*64;
  const char*Kbase=shm+LDS_K; bf16x8 kf[8];
  const lds_cptr shm3=(lds_cptr)shm; const lds_cptr kp0=shm3+LDS_K+hi*1024+r32*16; const lds_cptr vp0=shm3+LDS_V+((lane>>4)&1)*32+(lane&3)*8+(4*hi+((lane&15)>>2))*64;
  const int NT=(q0+QB)/KVBLK;
  DMA_K(0,0);DMA_V(0,0);DMA_K(1,SLOTB);
  bf16x8 qr[4];
  #pragma unroll
  for(int d0=0;d0<4;++d0)qr[d0]=*reinterpret_cast<const bf16x8*>(&Qw[(long)r32*DM+d0*16+hi*8]);
  if(qb>0){ const float*kmg=KMEAN+(((long)b*NHEAD+h)*NQB)*64; __attribute__((address_space(3))) char*kml=(__attribute__((address_space(3))) char*)((lds_cptr)shm+86016+wid*4096);
      typedef float f4v __attribute__((ext_vector_type(4))); f4v kv[4];
      #pragma unroll
      for(int r=0;r<4;++r){const int ch=r*64+lane; kv[r]=(ch<qb*16)?*reinterpret_cast<const f4v*>(kmg+ch*4):(f4v){0.f,0.f,0.f,0.f};}
      #pragma unroll
      for(int r=0;r<4;++r)*(__attribute__((address_space(3))) f4v*)(kml+(r*64+lane)*16)=kv[r];
      asm volatile("s_waitcnt lgkmcnt(0)":::"memory"); }
  #define USGPR(x) __uint_as_float((unsigned)__builtin_amdgcn_readfirstlane((int)__float_as_uint(x)))
  const float sl2=USGPR(__builtin_amdgcn_exp2f(-(float)(h+1))*1.4426950408889634f);
  const float sl2_64=USGPR(sl2*64.f);
  unsigned qmask=0u;
  if(qb>0){
    float qf[4][8];
    #pragma unroll
    for(int d0=0;d0<4;++d0){
      #pragma unroll
      for(int j=0;j<8;++j)qf[d0][j]=__uint_as_float(((unsigned)(unsigned short)qr[d0][j])<<16);}
    const __attribute__((address_space(3))) float*km=(const __attribute__((address_space(3))) float*)((lds_cptr)shm+86016+wid*4096)+8*hi;
    float g0=-INFINITY,g1=-INFINITY,g2=-INFINITY;int i0=-1,i1=-1,i2=-1;
    #pragma unroll 1
    for(int n=0;n<qb;++n){
      float s=0.f;
      #pragma unroll
      for(int d0=0;d0<4;++d0){
        typedef float f4w __attribute__((ext_vector_type(4))); const f4w a=*reinterpret_cast<const __attribute__((address_space(3))) f4w*>(km+n*64+16*d0),c=*reinterpret_cast<const __attribute__((address_space(3))) f4w*>(km+n*64+16*d0+4);
        s+=qf[d0][0]*a.x;s+=qf[d0][1]*a.y;s+=qf[d0][2]*a.z;s+=qf[d0][3]*a.w;s+=qf[d0][4]*c.x;s+=qf[d0][5]*c.y;s+=qf[d0][6]*c.z;s+=qf[d0][7]*c.w;}
      {auto rr=__builtin_amdgcn_permlane32_swap(__float_as_uint(s),__float_as_uint(s),false,false);s=__uint_as_float(rr[0])+__uint_as_float(rr[1]);}
      if(s>g0){g2=g1;i2=i1;g1=g0;i1=i0;g0=s;i0=n;}
      else if(s>g1){g2=g1;i2=i1;g1=s;i1=n;}
      else if(s>g2){g2=s;i2=n;}
    }
    qmask=(i0>=0?(1u<<i0):0u)|(i1>=0?(1u<<i1):0u)|(i2>=0?(1u<<i2):0u);
  }
  const __attribute__((address_space(3))) unsigned* qmp=(const __attribute__((address_space(3))) unsigned*)((lds_cptr)shm+LDS_WS+wid*256+r32*4+(83968-LDS_WS));
  *(__attribute__((address_space(3))) unsigned*)qmp=qmask;
  const float uA=USGPR(__builtin_amdgcn_exp2f(sl2)),uB1=USGPR(__builtin_amdgcn_exp2f(sl2*8.f));
  #define INNER(X,j) __builtin_fmaf(__builtin_fmaf(__builtin_fmaf(X[4*(j)+3],uA,X[4*(j)+2]),uA,X[4*(j)+1]),uA,X[4*(j)])
  asm volatile("s_waitcnt lgkmcnt(0)":::"memory");
  const lds_cptr qfp=(lds_cptr)shm+86016+wid*4096+lane*16;
  #pragma unroll
  for(int d0=0;d0<4;++d0)*(__attribute__((address_space(3))) bf16x8*)((__attribute__((address_space(3))) char*)qfp+d0*1024)=qr[d0];
  asm volatile("s_waitcnt lgkmcnt(0)":::"memory");
  #define QF(d0) (*(const __attribute__((address_space(3))) bf16x8*)(qfp+(d0)*1024))
  float mhat=0.f,l_reg=0.f;f32x16 o[2];o[0]=f32x16{};o[1]=f32x16{};f32x16 negm=f32x16{};asm volatile("":"+v"(negm));
  const int qrel=wid*QBLK+r32;
  #define TBIAS(t) ((((t)>=NT-4)||(((*qmp)>>((t)>>2))&1u))?sl2_64*(float)((t)-(NT-4)):-INFINITY)
  #define TBIASQ(t,QM) ((((t)>=NT-4)||(((QM)>>((t)>>2))&1u))?sl2_64*(float)((t)-(NT-4)):-INFINITY)
  #define CINITQ(t,QM) do{const float c_=TBIASQ(t,QM)-mhat; _Pragma("unroll") for(int r=0;r<16;++r)negm[r]=c_; asm volatile("":"+v"(negm));}while(0)
  #define CINIT(t) do{const float c_=TBIAS(t)-mhat; _Pragma("unroll") for(int r=0;r<16;++r)negm[r]=c_; asm volatile("":"+v"(negm));}while(0)
  #define CMASK(P0,P1,t) do{int jb_=(t)-(NT-4); if(jb_>=0)cmask(P0,P1,jb_,qrel,hi);}while(0)
  bool resc=false;
  #define START(P0,P1) do{ const float rm=rowmax(P0,P1); resc=false; \
    { const float dl=(rm==-INFINITY)?0.f:rm; mhat=fadd_s(mhat,dl); \
      _Pragma("unroll") for(int r=0;r<16;++r){P0[r]=fsub_s(P0[r],dl);P1[r]=fsub_s(P1[r],dl);} } \
    _Pragma("unroll") for(int r=0;r<16;++r)P0[r]=__builtin_amdgcn_exp2f(P0[r]); }while(0)
  #define RESC() do{ if(resc){ asm volatile("s_waitcnt lgkmcnt(0)":::"memory"); \
      _Pragma("unroll") for(int d_=0;d_<2;++d_) _Pragma("unroll") for(int r=0;r<16;++r)o[d_][r]*=wsf[crow(r,hi)]; } }while(0)
  f32x16 pA0,pA1,pB0,pB1;
  int sl_prev=0,sl_cur=0,sl_next=SLOTB;
  #define ROT() do{sl_prev=sl_cur;sl_cur=sl_next;sl_next=(sl_next==(NSLOT-1)*SLOTB)?0:sl_next+SLOTB;}while(0)
  DMA_K(2,2*SLOTB);
  WAIT_BAR(3);
  CINIT(0);
  qkt(pA0,pA1,Kbase,qr,negm,r32,hi);asm volatile("s_nop 15\n\ts_nop 7":"+v"(pA0),"+v"(pA1));CMASK(pA0,pA1,0);
  START(pA0,pA1);
  _Pragma("unroll") for(int r=0;r<16;++r)pA1[r]=__builtin_amdgcn_exp2f(pA1[r]);
  WAIT_BAR(0);
  DMA_K(3,0);DMA_V(1,SLOTB);
  ROT();
  kload8(kf,kp0+sl_cur);
  WAIT_BAR(2);
  s16x4 vlo[8],vhi[8]; u32x4 pw0,pw1,pw2,pw3;
  #define PKW(P,B) cvtpk_s(P[B],P[B+1])
  #define PAF(k) __builtin_bit_cast(bf16x8,pw##k)
  #define VFR(i) (bf16x8){vlo[i][0],vlo[i][1],vlo[i][2],vlo[i][3],vhi[i][0],vhi[i][1],vhi[i][2],vhi[i][3]}
  #define PIN(x) asm volatile("":"+v"(x))
  #define MX3(a,b,c) __builtin_fmaxf(__builtin_fmaxf((a),(b)),(c))
  #define GAPA(MF,F0,W0,W1,PW) do{ MF; F0; PIN(sacc); W0; W1; PIN(PW); SBAR(); }while(0)
  #define FNOP (void)0
  #define EX(v) __builtin_amdgcn_exp2f(v)
  #define GAPB(MF,X,B) do{ MF; X[B]=EX(X[B]); X[B+1]=EX(X[B+1]); X[B+2]=EX(X[B+2]); X[B+3]=EX(X[B+3]); PIN(X); SBAR(); }while(0)
  #define VRD(i) do{ vlo[i]=vtr(vp_+(((i)>>2)*4096+((i)&3)*1024)); vhi[i]=vtr(vp_+(((i)>>2)*4096+((i)&3)*1024+512)); }while(0)
  #define KRD(G,j) do{ if(G){ kload2(kf,kp0+sl_next,j); SBAR(); } }while(0)
  #define STEP(C0,C1,P0,P1,t,GK,GV,GL) do{ SBAR(); const bf16x8 q0_=QF(0),q1_=QF(1),q2_=QF(2),q3_=QF(3); CINIT(t); SBAR(); \
    const lds_cptr vp_=vp0+sl_prev; \
    VRD(0); SBAR(); float sacc; \
    GAPA(C0=__builtin_amdgcn_mfma_f32_32x32x16_bf16(kf[0],q0_,negm,0,0,0), sacc=INNER(P1,3),     pw0[0]=PKW(P0,0), pw0[1]=PKW(P0,2), pw0); \
    VRD(4); SBAR(); GAPA(C1=__builtin_amdgcn_mfma_f32_32x32x16_bf16(kf[1],q0_,negm,0,0,0), sacc=__builtin_fmaf(sacc,uB1,INNER(P1,2)),     pw0[2]=PKW(P0,4), pw0[3]=PKW(P0,6), pw0); \
    VRD(1); SBAR(); GAPA(C0=__builtin_amdgcn_mfma_f32_32x32x16_bf16(kf[2],q1_,C0,0,0,0),   sacc=__builtin_fmaf(sacc,uB1,INNER(P1,1)), pw1[0]=PKW(P0,8), pw1[1]=PKW(P0,10), pw1); \
    VRD(5); SBAR(); GAPA(C1=__builtin_amdgcn_mfma_f32_32x32x16_bf16(kf[3],q1_,C1,0,0,0),   sacc=__builtin_fmaf(sacc,uB1,INNER(P1,0)),   pw1[2]=PKW(P0,12),pw1[3]=PKW(P0,14), pw1); \
    VRD(2); SBAR(); GAPA(C0=__builtin_amdgcn_mfma_f32_32x32x16_bf16(kf[4],q2_,C0,0,0,0),   sacc=__builtin_fmaf(sacc,uB1,INNER(P0,3)),     pw2[0]=PKW(P1,0), pw2[1]=PKW(P1,2), pw2); \
    VRD(6); SBAR(); GAPA(C1=__builtin_amdgcn_mfma_f32_32x32x16_bf16(kf[5],q2_,C1,0,0,0),   sacc=__builtin_fmaf(sacc,uB1,INNER(P0,2)),     pw2[2]=PKW(P1,4), pw2[3]=PKW(P1,6), pw2); \
    VRD(3); SBAR(); GAPA(C0=__builtin_amdgcn_mfma_f32_32x32x16_bf16(kf[6],q3_,C0,0,0,0),   sacc=__builtin_fmaf(sacc,uB1,INNER(P0,1)), pw3[0]=PKW(P1,8), pw3[1]=PKW(P1,10), pw3); \
    VRD(7); SBAR(); GAPA(C1=__builtin_amdgcn_mfma_f32_32x32x16_bf16(kf[7],q3_,C1,0,0,0),   sacc=__builtin_fmaf(sacc,uB1,INNER(P0,0)),       pw3[2]=PKW(P1,12),pw3[3]=PKW(P1,14), pw3); \
    l_reg+=sacc; \
    if(GK){DMA_K((t)+3,sl_cur);} if(GV){DMA_V((t)+1,sl_next);} \
    CMASK(C0,C1,t); \
    { float a=MX3(C0[0],C0[1],C1[0]),b=MX3(C0[2],C0[3],C1[1]); a=MX3(a,C1[2],C1[3]); \
      _Pragma("unroll") for(int r=4;r<16;r+=4){a=MX3(a,C0[r],C0[r+1]);b=MX3(b,C0[r+2],C0[r+3]);a=MX3(a,C1[r],C1[r+1]);b=MX3(b,C1[r+2],C1[r+3]);} \
      float rm=__builtin_fmaxf(a,b); { auto rr=__builtin_amdgcn_permlane32_swap(__float_as_uint(rm),__float_as_uint(rm),false,false); rm=__builtin_fmaxf(__uint_as_float(rr[0]),__uint_as_float(rr[1])); } \
      resc=false; \
      if(__builtin_expect(__any(rm>(float)THRL),0)){ const float dl=__builtin_fmaxf(rm,0.f); mhat+=dl; \
        _Pragma("unroll") for(int r=0;r<16;++r){C0[r]-=dl;C1[r]-=dl;} \
        const float f=__builtin_amdgcn_exp2f(-dl); l_reg*=f; if(hi==0)wsf[r32]=f; resc=true; } } \
    SBAR(); \
    GAPB(o[0]=__builtin_amdgcn_mfma_f32_32x32x16_bf16(PAF(0),VFR(0),o[0],0,0,0), C0,0); \
    GAPB(o[1]=__builtin_amdgcn_mfma_f32_32x32x16_bf16(PAF(0),VFR(4),o[1],0,0,0), C0,4); \
    KRD(GL,0); GAPB(o[0]=__builtin_amdgcn_mfma_f32_32x32x16_bf16(PAF(1),VFR(1),o[0],0,0,0), C0,8); \
    KRD(GL,1); GAPB(o[1]=__builtin_amdgcn_mfma_f32_32x32x16_bf16(PAF(1),VFR(5),o[1],0,0,0), C0,12); \
    KRD(GL,2); GAPB(o[0]=__builtin_amdgcn_mfma_f32_32x32x16_bf16(PAF(2),VFR(2),o[0],0,0,0), C1,0); \
    KRD(GL,3); GAPB(o[1]=__builtin_amdgcn_mfma_f32_32x32x16_bf16(PAF(2),VFR(6),o[1],0,0,0), C1,4); \
    GAPB(o[0]=__builtin_amdgcn_mfma_f32_32x32x16_bf16(PAF(3),VFR(3),o[0],0,0,0), C1,8); \
    GAPB(o[1]=__builtin_amdgcn_mfma_f32_32x32x16_bf16(PAF(3),VFR(7),o[1],0,0,0), C1,12); \
    }while(0)
  int t=1;
  #undef CMASK
  #define CMASK(P0,P1,t) do{}while(0)
  for(;t+5<NT;t+=2){
    STEP(pB0,pB1,pA0,pA1,t,true,true,true);     WAIT_BAR(2); RESC(); ROT();
    STEP(pA0,pA1,pB0,pB1,t+1,true,true,true);   WAIT_BAR(2); RESC(); ROT();
  }
  #undef CMASK
  #define CMASK(P0,P1,t) do{int jb_=(t)-(NT-4); if(jb_>=0)cmask(P0,P1,jb_,qrel,hi);}while(0)
  #define ENDW(tt) do{ if((tt)+3<NT){WAIT_BAR(2);} else if((tt)+2<NT){WAIT_BAR(1);} else {WAIT_BAR(0);} }while(0)
  for(;t+1<NT;t+=2){
    STEP(pB0,pB1,pA0,pA1,t,(t+3<NT),(t+1<NT),(t+1<NT));       ENDW(t);   RESC(); ROT();
    STEP(pA0,pA1,pB0,pB1,t+1,(t+4<NT),(t+2<NT),(t+2<NT));     ENDW(t+1); RESC(); ROT();
  }
  STEP(pB0,pB1,pA0,pA1,NT-1,false,false,false); RESC();
  { float sacc=INNER(pB1,3); sacc=__builtin_fmaf(sacc,uB1,INNER(pB1,2)); sacc=__builtin_fmaf(sacc,uB1,INNER(pB1,1)); sacc=__builtin_fmaf(sacc,uB1,INNER(pB1,0)); sacc=__builtin_fmaf(sacc,uB1,INNER(pB0,3)); sacc=__builtin_fmaf(sacc,uB1,INNER(pB0,2)); sacc=__builtin_fmaf(sacc,uB1,INNER(pB0,1)); sacc=__builtin_fmaf(sacc,uB1,INNER(pB0,0)); l_reg+=sacc;
    pw0=(u32x4){PKW(pB0,0),PKW(pB0,2),PKW(pB0,4),PKW(pB0,6)};pw1=(u32x4){PKW(pB0,8),PKW(pB0,10),PKW(pB0,12),PKW(pB0,14)};pw2=(u32x4){PKW(pB1,0),PKW(pB1,2),PKW(pB1,4),PKW(pB1,6)};pw3=(u32x4){PKW(pB1,8),PKW(pB1,10),PKW(pB1,12),PKW(pB1,14)};
    SBAR(); pv(o,vb0+sl_cur,PAF(0),PAF(1),PAF(2),PAF(3)); }
  #undef PKW
  #undef PAF
  #undef VFR
  #undef PIN
  #undef MX3
  #undef GAPA
  #undef FNOP
  #undef GAPB
  #undef EX
  #undef VRD
  #undef KRD
  #undef STEP
  #undef ENDW
  l_reg*=(hi?__builtin_amdgcn_exp2f(sl2*4.f):1.0f);
  {auto rr=__builtin_amdgcn_permlane32_swap(__float_as_uint(l_reg),__float_as_uint(l_reg),false,false);l_reg=__uint_as_float(rr[0])+__uint_as_float(rr[1]);}
  if(hi==0)wsf[32+r32]=l_reg;asm volatile("s_waitcnt lgkmcnt(0)":::"memory");
  float rli[16];
  #pragma unroll
  for(int r=0;r<16;++r)rli[r]=__builtin_amdgcn_rcpf(wsf[32+crow(r,hi)]);
  unsigned char*Ow=(unsigned char*)O+(rowbase+q0+wid*QBLK)*OPITCH+h*D;
  { unsigned char*stg=(unsigned char*)(shm+LDS_OST)+wid*2048;
    #pragma unroll
    for(int r=0;r<16;++r){const int orow=crow(r,hi); const unsigned w=(unsigned)__builtin_amdgcn_cvt_pk_fp8_f32(o[0][r]*rli[r],o[1][r]*rli[r],0,false);
      stg[orow*64+r32]=(unsigned char)(w&0xffu); stg[orow*64+32+r32]=(unsigned char)((w>>8)&0xffu);}
    asm volatile("s_waitcnt lgkmcnt(0)":::"memory");
    #pragma unroll
    for(int i=0;i<2;++i){const int row=i*16+(lane>>2),ch=lane&3; const u32x4 v=*(const u32x4*)(stg+row*64+ch*16); ATTN_STORE16(Ow+(long)row*OPITCH+ch*16,v);} }
  asm volatile("s_waitcnt lgkmcnt(0)\n\ts_barrier":::"memory");
  #undef DMA_K
  #undef DMA_V
  #undef CMASK
  #undef START
  #undef RESC
  #undef ROT
  #undef TBIAS
  #undef TBIASQ
  #undef CINITQ
  #undef QF
  #undef USGPR
  #undef INNER
  #undef CINIT
}
constexpr int ATTN_LDS_BYTES=LDS_BYTES;
struct AttnTensors { const char* base; long oQ, oK, oV, oO, oKM; };
struct AttnUnit { int bh; int qb; };
struct StaticOrder {
  int vcu;
  __device__ __forceinline__ explicit StaticOrder(int grid,int block):vcu((block%8)*(grid/8)+block/8){}
  __device__ __forceinline__ bool next(int i,AttnUnit&u)const{ if(i>=4)return false; const int s=vcu&3; u.bh=vcu>>2; u.qb=(i==0)?15-s:(i==1)?8+s:(i==2)?7-s:s; return true; }
  __device__ __forceinline__ void a_ready(const AttnUnit&)const{}
  __device__ __forceinline__ void done(const AttnUnit&)const{}
};
template<class Sched,int THRL=8> __device__ __forceinline__ void attn_phase(char*lds,const AttnTensors&T,const Sched&S,const int wid){
  AttnUnit u;
  for(int i=0;S.next(i,u);++i){ S.a_ready(u); attn_unit<THRL>(u.bh/NHEAD,u.bh%NHEAD,u.qb,(const bf16*)(T.base+T.oQ),(const bf16*)(T.base+T.oK),(const bf16*)(T.base+T.oV),(bf16*)(T.base+T.oO),(const float*)(T.base+T.oKM),lds,wid); S.done(u); }
}
#undef SBAR
#undef WAIT_BAR
}

namespace gla {
typedef short bf16x8 __attribute__((ext_vector_type(8)));
typedef short s16x4 __attribute__((ext_vector_type(4)));
typedef float f32x4 __attribute__((ext_vector_type(4)));
typedef unsigned u32x4 __attribute__((ext_vector_type(4)));
typedef unsigned u32x2 __attribute__((ext_vector_type(2)));
typedef __attribute__((address_space(3))) unsigned char* lptr;
constexpr int S = 4096;
__device__ __forceinline__ s16x4 trd(lptr p) { return __builtin_bit_cast(s16x4, __builtin_amdgcn_ds_read_tr16_b64_v4i16((__attribute__((address_space(3))) s16x4*)p)); }
__device__ __forceinline__ bf16x8 cat8(s16x4 a, s16x4 b) { return (bf16x8){a[0], a[1], a[2], a[3], b[0], b[1], b[2], b[3]}; }
__device__ __forceinline__ unsigned pkbf(float lo, float hi) { return f2bf(lo) | (f2bf(hi) << 16); }
#define GLA_LW() asm volatile("s_waitcnt lgkmcnt(0)" ::: "memory")

struct Tensors { const bf16_t *QG, *KG, *VG, *RGS; const bf16_t* LA;     bf16_t* KVS; float* DEC; const float* g_gn; bf16_t* MIX; };

__device__ __forceinline__ void stage_v_load(const Tensors& T, size_t row0, int hg, int lane, u32x4 (&v)[16]) {
#pragma unroll
    for (int it = 0; it < 16; ++it) { const int id = it * 64 + lane, tok = id >> 4, ch = id & 15; v[it] = *(const u32x4*)(T.VG + (row0 + tok) * 512 + hg * 128 + ch * 8); }
}
__device__ __forceinline__ void stage_v_store(lptr wl, int lane, const u32x4 (&v)[16]) {
#pragma unroll
    for (int it = 0; it < 16; ++it) { const int id = it * 64 + lane, tok = id >> 4, ch = id & 15; *(__attribute__((address_space(3))) u32x4*)(wl + tok * 256 + ch * 16) = v[it]; }
}

__device__ __forceinline__ void tile_load8(const bf16_t* base, int lane, u32x4 (&v)[8]) {
#pragma unroll
    for (int r = 0; r < 8; ++r) v[r] = *(const u32x4*)(base + (size_t)(8 * r + (lane >> 3)) * 256 + 8 * (lane & 7));
}
__device__ __forceinline__ void tile_cols8(lptr sc, int lane, const u32x4 v, unsigned (&o)[8]) {
    *(__attribute__((address_space(3))) u32x4*)(sc + (lane >> 3) * 128 + (lane & 7) * 16) = v;
    GLA_LW();
#pragma unroll
    for (int tk = 0; tk < 8; ++tk) o[tk] = *(const __attribute__((address_space(3))) unsigned short*)(sc + tk * 128 + lane * 2);
    GLA_LW();
}

__device__ __forceinline__ void unit_a(const Tensors& T, int unit, lptr wl, lptr sc, int lane) {
    asm volatile("" : "+v"(lane));
    const int c = unit & 63, hg = (unit >> 6) & 3, b = unit >> 8; const size_t row0 = (size_t)b * S + (size_t)c * 64;
    const int i = lane & 15, g = lane >> 4;
    u32x4 vlo[8];
#pragma unroll
    for (int it = 8; it < 16; ++it) { const int id = it * 64 + lane, tok = id >> 4, ch = id & 15;
        __builtin_amdgcn_global_load_lds((const unsigned*)(T.VG + (row0 + tok) * 512 + hg * 128 + ch * 8), (__attribute__((address_space(3))) unsigned*)(wl + it * 1024), 16, 0, 0); }
#pragma unroll
    for (int it = 0; it < 8; ++it) { const int id = it * 64 + lane, tok = id >> 4, ch = id & 15; vlo[it] = *(const u32x4*)(T.VG + (row0 + tok) * 512 + hg * 128 + ch * 8); }
    {
        float G[64]; unsigned kr[64]; float run = 0.f;
        { u32x4 lw[8], kw[8]; tile_load8(T.LA + row0 * 256 + hg * 64, lane, lw); tile_load8(T.KG + row0 * 256 + hg * 64, lane, kw);
          __builtin_amdgcn_sched_barrier(0);
#pragma unroll
          for (int r = 0; r < 8; ++r) { unsigned o[8]; tile_cols8(sc, lane, lw[r], o);
#pragma unroll
              for (int tk = 0; tk < 8; ++tk) G[8 * r + tk] = __uint_as_float(o[tk] << 16); }
#pragma unroll
          for (int r = 0; r < 8; ++r) { unsigned o[8]; tile_cols8(sc, lane, kw[r], o);
#pragma unroll
              for (int tk = 0; tk < 8; ++tk) kr[8 * r + tk] = o[tk]; } }
#pragma unroll
        for (int t = 0; t < 64; ++t) { run += G[t]; G[t] = run; }
        const float gl = run;
#pragma unroll
        for (int t8 = 0; t8 < 8; ++t8) { float kt[8];
#pragma unroll
            for (int j = 0; j < 8; ++j) kt[j] = __uint_as_float(kr[8 * t8 + j] << 16) * __expf(gl - G[8 * t8 + j]);
            u32x4 w; w.x = pkbf(kt[0], kt[1]); w.y = pkbf(kt[2], kt[3]); w.z = pkbf(kt[4], kt[5]); w.w = pkbf(kt[6], kt[7]);
            *(__attribute__((address_space(3))) u32x4*)(wl + lane * 128 + t8 * 16) = w; }
        T.DEC[(size_t)unit * 64 + lane] = __expf(gl);
    }
    GLA_LW();
    bf16x8 afr[4][2];
#pragma unroll
    for (int mt = 0; mt < 4; ++mt)
#pragma unroll
        for (int ks = 0; ks < 2; ++ks) afr[mt][ks] = *(const __attribute__((address_space(3))) bf16x8*)(wl + (16 * mt + i) * 128 + (32 * ks + 8 * g) * 2);
    GLA_LW(); asm volatile("" ::: "memory");
#pragma unroll
    for (int it = 0; it < 8; ++it) *(__attribute__((address_space(3))) u32x4*)(wl + it * 1024 + lane * 16) = vlo[it];
    asm volatile("s_waitcnt vmcnt(0)" ::: "memory");
    GLA_LW(); asm volatile("" ::: "memory");
    bf16_t* kvo = T.KVS + (size_t)unit * 128 * 64;
#pragma unroll
    for (int nt = 0; nt < 8; ++nt) {
        f32x4 acc[4];
#pragma unroll
        for (int mt = 0; mt < 4; ++mt) acc[mt] = (f32x4){0.f, 0.f, 0.f, 0.f};
#pragma unroll
        for (int ks = 0; ks < 2; ++ks) {
            const lptr vb = wl + (32 * ks + 8 * g + (i >> 2)) * 256 + (16 * nt + 4 * (i & 3)) * 2;
            const s16x4 lo = trd(vb), hi = trd(vb + 4 * 256); const bf16x8 bfr = cat8(lo, hi);
#pragma unroll
            for (int mt = 0; mt < 4; ++mt) acc[mt] = __builtin_amdgcn_mfma_f32_16x16x32_bf16(afr[mt][ks], bfr, acc[mt], 0, 0, 0);
        }
        u32x2 w[4];
#pragma unroll
        for (int mt = 0; mt < 4; ++mt) { w[mt].x = pkbf(acc[mt][0], acc[mt][1]); w[mt].y = pkbf(acc[mt][2], acc[mt][3]); }
#pragma unroll
        for (int mp = 0; mp < 2; ++mp) {
            u32x2 a = w[2 * mp], b = w[2 * mp + 1];
            { auto r0 = __builtin_amdgcn_permlane16_swap(a.x, b.x, false, false); a.x = r0[0]; b.x = r0[1]; auto r1 = __builtin_amdgcn_permlane16_swap(a.y, b.y, false, false); a.y = r1[0]; b.y = r1[1]; }
            *(u32x4*)(kvo + (size_t)(16 * nt + i) * 64 + 16 * (2 * mp + (g & 1)) + 4 * (g - (g & 1))) = (u32x4){a.x, a.y, b.x, b.y}; }
    }
    GLA_LW(); asm volatile("" ::: "memory");
}

__device__ __forceinline__ void scan_item(const Tensors& T, int item  , int lane) {
    const int bh = item >> 5, e0 = (item & 31) * 256 + lane * 4, dk = e0 & 63;
    float s0 = 0.f, s1 = 0.f, s2 = 0.f, s3 = 0.f;
    bf16_t* p = T.KVS + (size_t)bh * 64 * 8192 + e0; const float* d = T.DEC + (size_t)bh * 64 * 64 + dk;
#pragma unroll 16
    for (int c = 0; c < 64; ++c) {
        const u32x2 kv = *(const u32x2*)(p + (size_t)c * 8192); const f32x4 dc = *(const f32x4*)(d + c * 64);
        u32x2 o; o.x = pkbf(s0, s1); o.y = pkbf(s2, s3); *(u32x2*)(p + (size_t)c * 8192) = o;
        s0 = dc[0] * s0 + __uint_as_float(kv.x << 16); s1 = dc[1] * s1 + __uint_as_float(kv.x & 0xffff0000u);
        s2 = dc[2] * s2 + __uint_as_float(kv.y << 16); s3 = dc[3] * s3 + __uint_as_float(kv.y & 0xffff0000u);
    }
}

__device__ __forceinline__ void unit_c(const Tensors& T, int unit, lptr wl, int lane) {
    asm volatile("" : "+v"(lane));
    const int c = unit & 63, hg = (unit >> 6) & 3, b = unit >> 8; const size_t row0 = (size_t)b * S + (size_t)c * 64;
    const int i = lane & 15, g = lane >> 4;
    u32x4 vreg[16]; stage_v_load(T, row0, hg, lane, vreg);
    {
        const bf16_t* la = T.LA + row0 * 256 + hg * 64 + lane; const bf16_t* qp = T.QG + row0 * 256 + hg * 64 + lane; const bf16_t* kp = T.KG + row0 * 256 + hg * 64 + lane;
        float run = 0.f;
#pragma unroll
        for (int hb = 0; hb < 2; ++hb) {
            float lav[32]; unsigned qr[32], kr[32];
#pragma unroll
            for (int t = 0; t < 32; ++t) { lav[t] = __uint_as_float((unsigned)la[(size_t)(32 * hb + t) * 256] << 16); qr[t] = qp[(size_t)(32 * hb + t) * 256]; kr[t] = kp[(size_t)(32 * hb + t) * 256]; }
            __builtin_amdgcn_sched_barrier(0);
#pragma unroll
            for (int t8 = 0; t8 < 4; ++t8) { float qd[8], kd[8];
#pragma unroll
                for (int j = 0; j < 8; ++j) { const int t = 8 * t8 + j; run += lav[t]; const float eg = __expf(run);
                    qd[j] = __uint_as_float(qr[t] << 16) * 0.125f * eg; kd[j] = __uint_as_float(kr[t] << 16) * __builtin_amdgcn_rcpf(eg); }
                u32x4 w; w.x = pkbf(qd[0], qd[1]); w.y = pkbf(qd[2], qd[3]); w.z = pkbf(qd[4], qd[5]); w.w = pkbf(qd[6], qd[7]);
                *(__attribute__((address_space(3))) u32x4*)(wl + lane * 128 + (4 * hb + t8) * 16) = w;
                w.x = pkbf(kd[0], kd[1]); w.y = pkbf(kd[2], kd[3]); w.z = pkbf(kd[4], kd[5]); w.w = pkbf(kd[6], kd[7]);
                *(__attribute__((address_space(3))) u32x4*)(wl + 8192 + lane * 128 + (4 * hb + t8) * 16) = w; }
            asm volatile("" ::: "memory");
        }
    }
    GLA_LW(); asm volatile("" ::: "memory");
    bf16x8 qdf[4][2], kdf[4][2];
#pragma unroll
    for (int tt = 0; tt < 4; ++tt)
#pragma unroll
        for (int ks = 0; ks < 2; ++ks) { const lptr qb = wl + (32 * ks + 8 * g + (i >> 2)) * 128 + (16 * tt + 4 * (i & 3)) * 2;
            qdf[tt][ks] = cat8(trd(qb), trd(qb + 4 * 128)); kdf[tt][ks] = cat8(trd(qb + 8192), trd(qb + 8192 + 4 * 128)); }
    GLA_LW(); asm volatile("" ::: "memory");
    stage_v_store(wl, lane, vreg);
    const bf16_t* sp = T.KVS + (size_t)unit * 8192;
    bf16x8 sf[8][2];
#pragma unroll
    for (int dvt = 0; dvt < 8; ++dvt)
#pragma unroll
        for (int ks = 0; ks < 2; ++ks) sf[dvt][ks] = *(const bf16x8*)(sp + (size_t)(16 * dvt + i) * 64 + 32 * ks + 8 * g);
    __builtin_amdgcn_sched_barrier(0);
    u32x2 at[4][4];
#pragma unroll
    for (int it = 0; it < 4; ++it)
#pragma unroll
        for (int jt = 0; jt < 4; ++jt) {
            if (jt > it) { at[it][jt] = (u32x2){0u, 0u}; continue; }
            f32x4 a = (f32x4){0.f, 0.f, 0.f, 0.f};
#pragma unroll
            for (int ks = 0; ks < 2; ++ks) a = __builtin_amdgcn_mfma_f32_16x16x32_bf16(kdf[jt][ks], qdf[it][ks], a, 0, 0, 0);
            if (jt == it) {
#pragma unroll
                for (int r = 0; r < 4; ++r) a[r] = (4 * g + r > i) ? 0.f : a[r]; }
            at[it][jt].x = pkbf(a[0], a[1]); at[it][jt].y = pkbf(a[2], a[3]);
        }
    GLA_LW(); asm volatile("" ::: "memory");
#pragma unroll
    for (int it = 0; it < 4; ++it) {
        f32x4 acc[8]; float ss = 0.f;
        u32x4 rgq[4];
#pragma unroll
        for (int dvp = 0; dvp < 4; ++dvp) rgq[dvp] = *(const u32x4*)(T.RGS + (row0 + 16 * it + i) * 512 + hg * 128 + 16 * (2 * dvp + (g & 1)) + 4 * (g - (g & 1)));
        __builtin_amdgcn_sched_barrier(0);
#pragma unroll
        for (int dvt = 0; dvt < 8; ++dvt) {
            f32x4 a = (f32x4){0.f, 0.f, 0.f, 0.f};
#pragma unroll
            for (int ks = 0; ks < 2; ++ks) a = __builtin_amdgcn_mfma_f32_16x16x32_bf16(sf[dvt][ks], qdf[it][ks], a, 0, 0, 0);
#pragma unroll
            for (int ks = 0; ks < 2; ++ks) { if (2 * ks > it) continue;
                const lptr vb = wl + (32 * ks + 4 * g + (i >> 2)) * 256 + (16 * dvt + 4 * (i & 3)) * 2;
                const bf16x8 vfr = cat8(trd(vb), trd(vb + 16 * 256));
                const u32x2 b0 = at[it][2 * ks], b1 = at[it][2 * ks + 1]; const u32x4 bw = (u32x4){b0.x, b0.y, b1.x, b1.y};
                a = __builtin_amdgcn_mfma_f32_16x16x32_bf16(vfr, __builtin_bit_cast(bf16x8, bw), a, 0, 0, 0); }
            acc[dvt] = a; ss += (a[0] * a[0] + a[1] * a[1]) + (a[2] * a[2] + a[3] * a[3]);
        }
        ss += __shfl_xor(ss, 16); ss += __shfl_xor(ss, 32);
        const float rn = 1.0f / sqrtf(ss * (1.0f / 128.0f) + 1e-6f);
        const size_t tok = row0 + 16 * it + i;
        u32x2 wpair[4];
#pragma unroll
        for (int dvp = 0; dvp < 4; ++dvp) { unsigned wo[2];
            u32x2 rlo = (u32x2){rgq[dvp].x, rgq[dvp].y}, rhi = (u32x2){rgq[dvp].z, rgq[dvp].w};
            { auto r0 = __builtin_amdgcn_permlane16_swap(rlo.x, rhi.x, false, false); rlo.x = r0[0]; rhi.x = r0[1]; auto r1 = __builtin_amdgcn_permlane16_swap(rlo.y, rhi.y, false, false); rlo.y = r1[0]; rhi.y = r1[1]; }
#pragma unroll
            for (int q = 0; q < 2; ++q) { const int dvt = 2 * dvp + q, dv = 16 * dvt + 4 * g; const f32x4 gg = *(const f32x4*)(T.g_gn + dv); const u32x2 rg = q ? rhi : rlo;
                const float o0 = acc[dvt][0] * rn * gg[0] * __uint_as_float(rg.x << 16), o1 = acc[dvt][1] * rn * gg[1] * __uint_as_float(rg.x & 0xffff0000u);
                const float o2 = acc[dvt][2] * rn * gg[2] * __uint_as_float(rg.y << 16), o3 = acc[dvt][3] * rn * gg[3] * __uint_as_float(rg.y & 0xffff0000u);
                int w = 0; w = __builtin_amdgcn_cvt_pk_fp8_f32(o0, o1, w, false); w = __builtin_amdgcn_cvt_pk_fp8_f32(o2, o3, w, true); wo[q] = (unsigned)w; }
            { auto r0 = __builtin_amdgcn_permlane16_swap(wo[0], wo[1], false, false); wo[0] = r0[0]; wo[1] = r0[1]; }
            wpair[dvp] = (u32x2){wo[0], wo[1]}; }
#pragma unroll
        for (int k2 = 0; k2 < 2; ++k2) { u32x2 a = wpair[2 * k2], b = wpair[2 * k2 + 1];
            { auto r0 = __builtin_amdgcn_permlane32_swap(a.x, b.x, false, false); a.x = r0[0]; b.x = r0[1]; auto r1 = __builtin_amdgcn_permlane32_swap(a.y, b.y, false, false); a.y = r1[0]; b.y = r1[1]; }
            const int tile = 4 * k2 + 2 * (g >> 1) + (g & 1);
            *(u32x4*)((unsigned char*)T.MIX + tok * 1024 + 512 + hg * 128 + 16 * tile) = (u32x4){a.x, a.y, b.x, b.y}; }
    }
    GLA_LW(); asm volatile("" ::: "memory");
}
#undef GLA_LW
}

#define GAS __attribute__((address_space(1)))
#define LAS __attribute__((address_space(3)))
typedef unsigned v4u __attribute__((ext_vector_type(4)));
typedef unsigned v2u __attribute__((ext_vector_type(2)));
typedef float f32x4 __attribute__((ext_vector_type(4)));
typedef GAS unsigned gu32;
#define RLX_AGENT __ATOMIC_RELAXED, __HIP_MEMORY_SCOPE_AGENT
#define LDS_WAIT() asm volatile("s_waitcnt lgkmcnt(0)" ::: "memory")
#define VM_WAIT() asm volatile("s_waitcnt vmcnt(0)" ::: "memory")
__device__ __forceinline__ unsigned pk2(float lo, float hi) { return f2bf(lo) | (f2bf(hi) << 16); }


#define XB_TMO      128
#define XB_XCNT(j)  (256  + 64 * (j))
#define XB_XSUB(j)  (1280 + 64 * (j))
#define XB_XGEN(j)  (2304 + 64 * (j))
#define XB_TOP      3328
#define XB_TOPGEN   3392
#define XCD_BAR_WORDS 3456
#define XB_SPIN_CAP (1u << 18)

__device__ __forceinline__ unsigned xb_ld(unsigned* p)              { return __hip_atomic_load(p, __ATOMIC_RELAXED, __HIP_MEMORY_SCOPE_AGENT); }
__device__ __forceinline__ unsigned xb_add(unsigned* p, unsigned v) { return __hip_atomic_fetch_add(p, v, __ATOMIC_RELAXED, __HIP_MEMORY_SCOPE_AGENT); }
__device__ __forceinline__ unsigned xb_xcc_id() { return (unsigned)__builtin_amdgcn_s_getreg((3 << 11) | 20) & 0xFu; }
#define XB_SPIN(cond, bar) do { unsigned _sp = 0; while (cond) { __builtin_amdgcn_s_sleep(1); \
    if ((++_sp & 255u) == 0u) { if (xb_ld(&(bar)[XB_TMO])) break; if (_sp > XB_SPIN_CAP) { atomicAdd(&(bar)[XB_TMO], 1u); break; } } } } while (0)

struct XcdBarrier {
    unsigned* bar; unsigned x;
    volatile LAS unsigned* st;
};

__device__ __forceinline__ XcdBarrier xcd_barrier_post(unsigned* bar, volatile LAS unsigned* st, const bool leader) {
    XcdBarrier b; b.bar = bar; b.x = xb_xcc_id(); b.st = st;
    if (leader) (void)xb_add(&bar[XB_XCNT(b.x)], 1u);
    return b;
}
__device__ __forceinline__ void xcd_barrier_complete(unsigned* bar, unsigned x, unsigned& nloc, unsigned& nx) {
    const unsigned G = gridDim.x * gridDim.y * gridDim.z;
    unsigned sum, cnt, mine, sp = 0u;
    for (;;) {
        sum = 0u; cnt = 0u; mine = 0u;
#pragma unroll
        for (unsigned j = 0; j < 16; ++j) { const unsigned c = xb_ld(&bar[XB_XCNT(j)]); sum += c; cnt += (c > 0u) ? 1u : 0u; mine = (j == x) ? c : mine; }
        if (sum == G) break;
        __builtin_amdgcn_s_sleep(1);
        if ((++sp & 255u) == 0u) { if (xb_ld(&bar[XB_TMO])) break; if (sp > XB_SPIN_CAP) { atomicAdd(&bar[XB_TMO], 1u); break; } }
    }
    nloc = mine > 0u ? mine : 1u; nx = cnt > 0u ? cnt : 1u;
}

__device__ __forceinline__ void xcd_barrier(const XcdBarrier& b, const bool leader) {
    asm volatile("s_waitcnt vmcnt(0)" ::: "memory");
    __syncthreads();
    if (leader) {
        unsigned* bar = b.bar;
        __builtin_amdgcn_s_waitcnt(0);
        unsigned nloc = b.st[0], nx = b.st[1];
        if (nloc == 0u) { xcd_barrier_complete(bar, b.x, nloc, nx); b.st[0] = nloc; b.st[1] = nx; }
        const unsigned old = xb_add(&bar[XB_XSUB(b.x)], 1u);
        const unsigned gen = old / nloc;
        if (old + 1u == (gen + 1u) * nloc) {
            __builtin_amdgcn_fence(__ATOMIC_RELEASE, "agent");
            asm volatile("s_waitcnt vmcnt(0)" ::: "memory");
            const unsigned og = xb_add(&bar[XB_TOP], 1u);
            const unsigned tg = og / nx;
            if (og + 1u == (tg + 1u) * nx) xb_add(&bar[XB_TOPGEN], 1u);
            else XB_SPIN(xb_ld(&bar[XB_TOPGEN]) == tg, bar);
            __builtin_amdgcn_fence(__ATOMIC_ACQUIRE, "agent");
            xb_add(&bar[XB_XGEN(b.x)], 1u);
            asm volatile("s_waitcnt vmcnt(0)" ::: "memory");
        } else {
            XB_SPIN(xb_ld(&bar[XB_XGEN(b.x)]) == gen, bar);
            __builtin_amdgcn_fence(__ATOMIC_ACQUIRE, "agent");
            asm volatile("s_waitcnt vmcnt(0)" ::: "memory");
        }
    }
    __syncthreads();
}

#ifndef DBG_NOKM
#define DBG_NOKM 0
#endif
#ifndef DBG_NOLA
#define DBG_NOLA 0
#endif
#ifndef DBG_NOMID
#define DBG_NOMID 0
#endif
#ifndef DBG_NOPLE
#define DBG_NOPLE 0
#endif
#ifndef DBG_NOPROJ
#define DBG_NOPROJ 0
#endif
#ifndef PROBE_REP_PHASE
#define PROBE_REP_PHASE -1
#endif
#ifndef PROBE_REP_N
#define PROBE_REP_N 2
#endif
#ifndef MOE2_F8
#define MOE2_F8 true
#endif
namespace mk {
using pg8::Unit;
constexpr int NWAVES = 8, NPHASES = 12;
constexpr int B = 8, S = 4096, D = 1024, T = B * S, NPROJ = 3328;
constexpr float LOG2E = 1.4426950408889634f, C2 = 0.125f * LOG2E, EPS = 1e-6f;
constexpr size_t MiB = 1u << 20;
constexpr size_t WS_CTL = 0, CTL_ZERO_BYTES = 80 * 1024;
constexpr size_t WS_DEC = 1 * MiB, WS_RPLE = 1 * MiB + 512 * 1024;
constexpr size_t WS_WIN = 2 * MiB, WS_WOUT = 9 * MiB, WS_WPG = 11 * MiB, WS_WPP = 13 * MiB;
constexpr size_t WS_WR = 13 * MiB + 512 * 1024, WS_KMEAN = 13 * MiB + 768 * 1024;
constexpr size_t WS_SSQ_PLE = 14 * MiB, WS_SSQ_H1 = 16 * MiB, WS_SSQ_H3 = 18 * MiB;
constexpr size_t WS_LIST = 20 * MiB, WS_RLIST = 24 * MiB, WS_GLIST = 28 * MiB, WS_TOPE = 32 * MiB, WS_TPOS = 33 * MiB;
constexpr size_t WS_W1 = 34 * MiB, WS_W2 = 162 * MiB, WS_H1F8 = 194 * MiB;
constexpr size_t WS_PPRE = 226 * MiB, WS_H1 = 290 * MiB;
constexpr size_t WS_XN = 354 * MiB, WS_PB = 418 * MiB, WS_QA = 434 * MiB, WS_KA = 466 * MiB, WS_VA = 498 * MiB, WS_QG = 530 * MiB, WS_KG = 546 * MiB, WS_VG = 562 * MiB, WS_RGS = 594 * MiB, WS_LA = 626 * MiB;
constexpr size_t WS_MIX = 658 * MiB, WS_KVS = 722 * MiB;
constexpr size_t WS_HID = 354 * MiB, WS_Y = 626 * MiB;
constexpr size_t WS_H3 = 354 * MiB, WS_H2F8 = WS_H1F8, WS_H2 = 898 * MiB;
static_assert(WS_VA - WS_KA == WS_KA - WS_QA && WS_KG - WS_QG == 16 * MiB && WS_RGS - WS_VG == 32 * MiB, "ws map");
constexpr int HROWS = (T * 4 / 256 + 32) * 256;
static_assert(WS_HID + (size_t)HROWS * 1024 * 2 <= WS_Y && WS_Y + (size_t)HROWS * 1024 * 2 <= 1024 * MiB && WS_KVS + 32 * MiB <= 1024 * MiB, "ws map 2");
constexpr int CW_TMO = 0, CW_CODE = 1, CW_BAR = 4096, CW_CNT = 16384;
constexpr int RING_OFF = 0, RING_BYTES = 131072, LDSCTL_OFF = RING_BYTES, MISC_OFF = LDSCTL_OFF + 320, TAB_OFF = LDSCTL_OFF + 1024  , LDS_BYTES = 147456;

typedef const __attribute__((address_space(4))) char* kptr_t;
__device__ __forceinline__ const float* mk_karg(kptr_t kp, int off) { asm volatile("" : "+s"(kp)); return *(const float* const __attribute__((address_space(4)))*)(kp + off); }
#define INP(i) mk_karg(F.kp, 8 * (i))
struct Frame {
    LAS unsigned char* lds; volatile LAS unsigned* MISC; gu32* ctl;
    int wave, vcu, G;
    kptr_t kp;
    unsigned char* ws;
};
__device__ __forceinline__ float wave_sum(float v) {
#pragma unroll
    for (int o = 1; o < 64; o <<= 1) v += __shfl_xor(v, o);
    return v;
}

__device__ __forceinline__ void p0_tile(const float* W, int ldw, int k0, int n0, bf16_t* WT, int ldt, int trow, const float* ksc, LAS float* scr, int lane) {
#pragma unroll
    for (int i = 0; i < 8; ++i) { const int kk = 8 * i + (lane >> 3), nn = 4 * (lane & 7);
        f32x4 v = *(const GAS f32x4*)(W + (size_t)(k0 + kk) * ldw + n0 + nn); if (ksc) v = v * ksc[k0 + kk];
        scr[kk * 33 + nn] = v.x; scr[kk * 33 + nn + 1] = v.y; scr[kk * 33 + nn + 2] = v.z; scr[kk * 33 + nn + 3] = v.w; }
    LDS_WAIT(); asm volatile("" ::: "memory");
    const int c = lane >> 3, nl = lane & 7;
#pragma unroll
    for (int j = 0; j < 4; ++j) { const int n = 8 * j + nl; const LAS float* s = scr + (8 * c) * 33 + n;
        v4u o; o.x = pk2(s[0 * 33], s[1 * 33]); o.y = pk2(s[2 * 33], s[3 * 33]); o.z = pk2(s[4 * 33], s[5 * 33]); o.w = pk2(s[6 * 33], s[7 * 33]);
        *(GAS v4u*)(WT + (size_t)(trow + n0 + n) * ldt + k0 + 8 * c) = o; }
    LDS_WAIT(); asm volatile("" ::: "memory");
}
__device__ __forceinline__ void p0_tile_f8(const float* W, int ldw, int k0, int n0, unsigned char* WT8, int ldt, const float* ksc, float mul, LAS float* scr, int lane) {
#pragma unroll
    for (int i = 0; i < 8; ++i) { const int kk = 8 * i + (lane >> 3), nn = 4 * (lane & 7);
        f32x4 v = *(const GAS f32x4*)(W + (size_t)(k0 + kk) * ldw + n0 + nn); v = v * (ksc ? ksc[k0 + kk] * mul : mul);
        scr[kk * 33 + nn] = v.x; scr[kk * 33 + nn + 1] = v.y; scr[kk * 33 + nn + 2] = v.z; scr[kk * 33 + nn + 3] = v.w; }
    LDS_WAIT(); asm volatile("" ::: "memory");
    const int c = lane >> 3, nl = lane & 7;
#pragma unroll
    for (int j = 0; j < 4; ++j) { const int n = 8 * j + nl; const LAS float* s = scr + (8 * c) * 33 + n;
        v2u o; o.x = pg8::pk4_fp8(s[0 * 33], s[1 * 33], s[2 * 33], s[3 * 33]); o.y = pg8::pk4_fp8(s[4 * 33], s[5 * 33], s[6 * 33], s[7 * 33]);
        *(GAS v2u*)(WT8 + (size_t)(n0 + n) * ldt + k0 + 8 * c) = o; }
    LDS_WAIT(); asm volatile("" ::: "memory");
}
__device__ __forceinline__ void p0_comb_tile(const float* w_in, const float* w_gg, int k0, int n0, bf16_t* WT, LAS float* scr, int lane) {
    const int jj = lane & 31; float g[16];
#pragma unroll
    for (int r = 0; r < 16; ++r) g[r] = w_gg[r * 256 + n0 + jj];
    for (int i = 0; i < 32; ++i) { const int kk = 2 * i + (lane >> 5); const float* wr = w_in + (size_t)(k0 + kk) * 3088 + 3072; float s = 0.f;
#pragma unroll
        for (int r = 0; r < 16; ++r) s += wr[r] * g[r];
        scr[kk * 33 + jj] = s; }
    LDS_WAIT(); asm volatile("" ::: "memory");
    const int c = lane >> 3, nl = lane & 7;
#pragma unroll
    for (int j = 0; j < 4; ++j) { const int n = 8 * j + nl; const LAS float* s = scr + (8 * c) * 33 + n;
        v4u o; o.x = pk2(s[0 * 33], s[1 * 33]); o.y = pk2(s[2 * 33], s[3 * 33]); o.z = pk2(s[4 * 33], s[5 * 33]); o.w = pk2(s[6 * 33], s[7 * 33]);
        *(GAS v4u*)(WT + (size_t)(3072 + n0 + n) * 1024 + k0 + 8 * c) = o; }
    LDS_WAIT(); asm volatile("" ::: "memory");
}
struct P0TD { const float* src; const float* ksc; unsigned char* dst; int ldw; };
__device__ __forceinline__ P0TD p0_w12_decode(int r, const float* w1, const float* w2, const float* gffn, unsigned char* W1_8, unsigned char* W2_8) {
    P0TD d;
    if (r < 32 * 8 * 64) { const int e = r >> 9, q = r & 511, k0 = 128 * (q >> 6), n0 = 32 * (q & 63); d.src = w1 + (size_t)e * 1024 * 2048 + (size_t)k0 * 2048 + n0; d.ldw = 2048; d.ksc = gffn + k0; d.dst = W1_8 + (size_t)e * 2048 * 1024 + (size_t)n0 * 1024 + k0; }
    else { r -= 32 * 8 * 64; const int e = r >> 8, q = r & 255, k0 = 128 * (q >> 5), n0 = 32 * (q & 31); d.src = w2 + (size_t)e * 1024 * 1024 + (size_t)k0 * 1024 + n0; d.ldw = 1024; d.ksc = nullptr; d.dst = W2_8 + (size_t)e * 1024 * 1024 + (size_t)n0 * 1024 + k0; }
    return d;
}
__device__ __forceinline__ void p0_w12_load(const P0TD& d, int lane, f32x4 (&v)[16], float (&sc)[16]) {
#pragma unroll
    for (int i = 0; i < 16; ++i) { const int kk = 32 * (i >> 2) + 4 * (lane >> 3) + (i & 3); v[i] = __builtin_nontemporal_load((const GAS f32x4*)(d.src + (size_t)kk * d.ldw + 4 * (lane & 7))); sc[i] = d.ksc ? d.ksc[kk] * 64.0f : 64.0f; }
}
__device__ __forceinline__ void p0_w12_store(const P0TD& d, int lane, const f32x4 (&v)[16], const float (&sc)[16], LAS float* scr) {
    LAS unsigned* s32 = (LAS unsigned*)scr;
#pragma unroll
    for (int g = 0; g < 4; ++g)
#pragma unroll
        for (int c = 0; c < 4; ++c)
            s32[(4 * (lane & 7) + c) * 33 + (lane >> 3) + 8 * g] = pg8::pk4_fp8(v[4 * g][c] * sc[4 * g], v[4 * g + 1][c] * sc[4 * g + 1], v[4 * g + 2][c] * sc[4 * g + 2], v[4 * g + 3][c] * sc[4 * g + 3]);
    LDS_WAIT(); asm volatile("" ::: "memory");
#pragma unroll
    for (int r = 0; r < 4; ++r) { const int n = 8 * r + (lane >> 3), p4 = 4 * (lane & 7); const LAS unsigned* s = s32 + n * 33 + p4;
        v4u o; o.x = s[0]; o.y = s[1]; o.z = s[2]; o.w = s[3];
        __builtin_nontemporal_store(o, (GAS v4u*)(d.dst + (size_t)n * 1024 + 4 * p4)); }
    LDS_WAIT(); asm volatile("" ::: "memory");
}
#ifndef PROBE_P0MODE
#define PROBE_P0MODE 0
#endif
__device__ __forceinline__ void p0_prologue(Frame& F, const int mode = 0) {
    LAS float* scr = (LAS float*)(F.lds + RING_OFF + F.wave * 16384);
    const int gw = F.vcu * NWAVES + F.wave, NGW = F.G * NWAVES, lane = mk_lane_id();
    const float *in_x = INP(0), *in_p = INP(1), *in_gmix = INP(2), *in_win = INP(3), *in_wgg = INP(4), *in_wout = INP(7), *in_gffn = INP(8), *in_wr = INP(9), *in_w1 = INP(11), *in_w2 = INP(13), *in_wpg = INP(15), *in_wpp = INP(16);
    bf16_t* WIN_T = (bf16_t*)(F.ws + WS_WIN); bf16_t* WOUT_T = (bf16_t*)(F.ws + WS_WOUT); bf16_t* WPG_T = (bf16_t*)(F.ws + WS_WPG); bf16_t* WPP_T = (bf16_t*)(F.ws + WS_WPP);
    bf16_t* WR_T = (bf16_t*)(F.ws + WS_WR); unsigned char* W1_8 = F.ws + WS_W1; unsigned char* W2_8 = F.ws + WS_W2;
    constexpr int I_WIN = 16 * 96, I_COMB = 16 * 8, I_WOUT = 16 * 32, I_WPG = 16 * 32, I_WPP = 4 * 32, I_WR = 16, I_W1 = 32 * 8 * 64, I_W2 = 32 * 8 * 32;
    constexpr int NITEMS = I_WIN + I_COMB + I_WOUT + I_WPG + I_WPP + I_WR;
    if (PROBE_P0MODE == 0 || mode == 0)
    for (int it = gw; it < NITEMS; it += NGW) {
        int r = it;
        if (r < I_WIN) { p0_tile(in_win, 3088, 64 * (r / 96), 32 * (r % 96), WIN_T, 1024, 0, nullptr, scr, lane); continue; } r -= I_WIN;
        if (r < I_COMB) { p0_comb_tile(in_win, in_wgg, 64 * (r / 8), 32 * (r % 8), WIN_T, scr, lane); continue; } r -= I_COMB;
        if (r < I_WOUT) { p0_tile_f8(in_wout, 1024, 64 * (r / 32), 32 * (r % 32), (unsigned char*)WOUT_T, 1024, nullptr, 64.0f, scr, lane); continue; } r -= I_WOUT;
        if (r < I_WPG) { p0_tile_f8(in_wpg, 1024, 64 * (r / 32), 32 * (r % 32), (unsigned char*)WPG_T, 1024, nullptr, 64.0f, scr, lane); continue; } r -= I_WPG;
        if (r < I_WPP) { p0_tile_f8(in_wpp, 1024, 64 * (r / 32), 32 * (r % 32), (unsigned char*)WPP_T, 256, nullptr, 64.0f, scr, lane); continue; } r -= I_WPP;
        { p0_tile(in_wr, 32, 64 * r, 0, WR_T, 1024, 0, in_gffn, scr, lane); }
    }
    {
        constexpr int NW12 = I_W1 + I_W2;
        int it = gw;
#if PROBE_P0MODE == 2
        if (mode) { float accs = 0.f;
#pragma unroll 1
            for (; it < NW12; it += NGW) { P0TD d0 = p0_w12_decode(it, in_w1, in_w2, in_gffn, W1_8, W2_8);
                f32x4 v0[16]; float s0[16]; p0_w12_load(d0, lane, v0, s0);
#pragma unroll
                for (int i = 0; i < 16; ++i) accs += (v0[i].x + v0[i].y) * s0[i] + (v0[i].z + v0[i].w); }
            if (accs == 1.2345e-30f) scr[lane] = accs;
            return;
        }
#endif
        if (it < NW12) {
            P0TD d0 = p0_w12_decode(it, in_w1, in_w2, in_gffn, W1_8, W2_8); f32x4 v0[16]; float s0[16]; p0_w12_load(d0, lane, v0, s0);
            for (;;) {
                const int itn = it + NGW; const bool more = itn < NW12;
                P0TD d1 = d0; f32x4 v1[16]; float s1[16];
                if (more) { d1 = p0_w12_decode(itn, in_w1, in_w2, in_gffn, W1_8, W2_8); p0_w12_load(d1, lane, v1, s1); }
                p0_w12_store(d0, lane, v0, s0, scr);
                if (!more) break;
                d0 = d1; it = itn;
#pragma unroll
                for (int i = 0; i < 16; ++i) { v0[i] = v1[i]; s0[i] = s1[i]; }
            }
        }
    }
    if (PROBE_P0MODE != 0 && mode != 0) return;
    bf16_t* XN = (bf16_t*)(F.ws + WS_XN);
    {
        f32x4 gm[4];
#pragma unroll
        for (int j = 0; j < 4; ++j) gm[j] = ((const GAS f32x4*)in_gmix)[64 * j + lane];
        int m = gw; f32x4 v[4];
        if (m < T) {
#pragma unroll
            for (int j = 0; j < 4; ++j) v[j] = __builtin_nontemporal_load((const GAS f32x4*)(in_x + (size_t)m * D) + lane + 64 * j);
        }
        while (m < T) {
            const int mn = m + NGW; f32x4 vn[4];
            if (mn < T) {
#pragma unroll
                for (int j = 0; j < 4; ++j) vn[j] = __builtin_nontemporal_load((const GAS f32x4*)(in_x + (size_t)mn * D) + lane + 64 * j);
            }
            float s = 0.f;
#pragma unroll
            for (int j = 0; j < 4; ++j) s += (v[j].x * v[j].x + v[j].y * v[j].y) + (v[j].z * v[j].z + v[j].w * v[j].w);
            const float rs = 1.0f / sqrtf(wave_sum(s) * (1.0f / D) + EPS);
            GAS v2u* o8 = (GAS v2u*)(XN + (size_t)m * D) + lane;
#pragma unroll
            for (int j = 0; j < 4; ++j) { v2u o; o.x = pk2(v[j].x * rs * gm[j].x, v[j].y * rs * gm[j].y); o.y = pk2(v[j].z * rs * gm[j].z, v[j].w * rs * gm[j].w); o8[64 * j] = o; }
#pragma unroll
            for (int j = 0; j < 4; ++j) v[j] = vn[j];
            m = mn;
        }
    }
    unsigned char* PB = F.ws + WS_PB;
    for (int m = gw; m < T / 4; m += 2 * NGW) {
        const int m2 = m + NGW; const bool two = m2 < T / 4;
        const GAS f32x4* xr = (const GAS f32x4*)(in_p + (size_t)m * 1024) + lane; const GAS f32x4* xr2 = (const GAS f32x4*)(in_p + (size_t)(two ? m2 : m) * 1024) + lane;
        f32x4 a[4], c[4];
#pragma unroll
        for (int j = 0; j < 4; ++j) { a[j] = __builtin_nontemporal_load(xr + 64 * j); c[j] = __builtin_nontemporal_load(xr2 + 64 * j); }
        GAS unsigned* o8 = (GAS unsigned*)(PB + (size_t)m * 1024) + lane; GAS unsigned* o82 = (GAS unsigned*)(PB + (size_t)m2 * 1024) + lane;
#pragma unroll
        for (int j = 0; j < 4; ++j) o8[64 * j] = pg8::pk4_fp8(a[j].x, a[j].y, a[j].z, a[j].w);
        if (two) {
#pragma unroll
            for (int j = 0; j < 4; ++j) o82[64 * j] = pg8::pk4_fp8(c[j].x, c[j].y, c[j].z, c[j].w); }
    }
    float* KM = (float*)(F.ws + WS_KMEAN);
    for (int i = gw * 64 + lane; i < B * 8 * 16 * 64; i += NGW * 64) KM[i] = 0.f;
}

__device__ __forceinline__ float fast_sigm(float x) { return __builtin_amdgcn_rcpf(1.0f + __expf(-x)); }
struct ProjProb {
    static constexpr bool LIST_DMA = false, PERM64 = true, EPI_DMA = false, PERM = true, F8 = false, GATHER = false; static constexpr int SCALE_A = 0, SCALE_B = 0;
    static constexpr int K = 1024; const bf16_t* A; const bf16_t* Bt; pg8::StaticOrder ord;
    unsigned char* ws; float *LA, *KMEAN; const float* bgg;
    __device__ __forceinline__ bool next(int i, Unit& u) const { if (ord.G != 256) return ord.next(i, u); if (i < 6) return ord.at((long)i * 256 + ord.c, u); if (i == 6 && ord.c >= 128) return ord.at(1536 + (ord.c - 128), u); return false; }
    __device__ __forceinline__ const char* a_base(const Unit& u) const { return (const char*)A + (size_t)u.pm * 256 * K * 2; }
    __device__ __forceinline__ void a_offs(const Unit&, int tid, unsigned (&o)[2][2]) const {
#pragma unroll
        for (int i = 0; i < 2; ++i) { int R, C; pg8::stage_rc(tid * 16 + i * 8192, R, C);
#pragma unroll
            for (int h = 0; h < 2; ++h) o[h][i] = (unsigned)((h * 128 + R) * K + C) * 2u; } }
    __device__ __forceinline__ const char* b_base(const Unit& u) const { return (const char*)Bt + (size_t)u.pn * 256 * K * 2; }
    __device__ __forceinline__ void epilogue(const pg8::f32x4 (&acc)[2][2][4][2], const Unit& u, int wr, int wc, int fr, int fq) const {
        const int row0 = u.pm * 256 + wr * 64 + fr, cw = wc * 64 + 16 * fq, pn = u.pn;
        if (pn < 6) {
            const int which = pn >> 1; bf16_t* base = (bf16_t*)(ws + WS_QA + (size_t)which * (WS_KA - WS_QA)); const int colt = (pn & 1) * 256 + cw;
            const float sl2 = exp2f(-(float)((pn & 1) * 4 + wc + 1)) * LOG2E;
#pragma unroll
            for (int ai = 0; ai < 2; ++ai)
#pragma unroll
                for (int m = 0; m < 4; ++m) { bf16_t* rowp = base + (size_t)(row0 - 8 * (fr >> 3) + ai * 128 + m * 16) * 512 + colt + 8 * (fr >> 3); pg8::u32x4 w[2];
#pragma unroll
                    for (int bj = 0; bj < 2; ++bj) { pg8::f32x4 v0 = acc[ai][bj][m][0], v1 = acc[ai][bj][m][1];
                        float sc = 1.0f; if (which == 0) sc = C2; else if (which == 2) sc = exp2f(sl2 * (float)(16 * m + fr));
                        v0 = v0 * sc; v1 = v1 * sc; w[bj] = pg8::pack8(v0, v1); }
                    pg8::st_rows16(rowp, (size_t)8 * 512, w[0], w[1], fr >= 8); }
            if (which == 1 && !DBG_NOKM) {
                const int b = u.pm >> 4, nb = u.pm & 15;
#pragma unroll
                for (int bj = 0; bj < 2; ++bj)
#pragma unroll
                    for (int n = 0; n < 2; ++n) { pg8::f32x4 cs = (pg8::f32x4){0.f, 0.f, 0.f, 0.f};
#pragma unroll
                        for (int ai = 0; ai < 2; ++ai)
#pragma unroll
                            for (int m = 0; m < 4; ++m) cs = cs + acc[ai][bj][m][n];
#pragma unroll
                        for (int j = 0; j < 4; ++j) { float s = cs[j]; s += __shfl_xor(s, 1); s += __shfl_xor(s, 2); s += __shfl_xor(s, 4); s += __shfl_xor(s, 8);
                            const int col = colt + bj * 8 + 4 * n + j; if (fr == 0) atomicAdd(KMEAN + (((size_t)b * 8 + (col >> 6)) * 16 + nb) * 64 + (col & 63), s * (1.0f / 256.0f)); } }
            }
        } else if (pn < 12 && !DBG_NOMID) {
            bf16_t* base; int ld, colt; bool silu = false;
            if (pn < 8) { base = (bf16_t*)(ws + WS_QG + (size_t)(pn - 6) * (WS_KG - WS_QG)); ld = 256; colt = cw; }
            else { base = (bf16_t*)(ws + WS_VG + (size_t)((pn - 8) >> 1) * (WS_RGS - WS_VG)); ld = 512; colt = ((pn - 8) & 1) * 256 + cw; silu = pn >= 10; }
#pragma unroll
            for (int ai = 0; ai < 2; ++ai)
#pragma unroll
                for (int m = 0; m < 4; ++m) { bf16_t* rowp = base + (size_t)(row0 - 8 * (fr >> 3) + ai * 128 + m * 16) * ld + colt + 8 * (fr >> 3); pg8::u32x4 w[2];
#pragma unroll
                    for (int bj = 0; bj < 2; ++bj) { pg8::f32x4 v0 = acc[ai][bj][m][0], v1 = acc[ai][bj][m][1];
                        if (silu) {
#pragma unroll
                            for (int j = 0; j < 4; ++j) { v0[j] = v0[j] * fast_sigm(v0[j]); v1[j] = v1[j] * fast_sigm(v1[j]); } }
                        w[bj] = pg8::pack8(v0, v1); }
                    pg8::st_rows16(rowp, (size_t)8 * ld, w[0], w[1], fr >= 8); }
        } else if (!DBG_NOLA) {
            pg8::f32x4 bb[2][2];
#pragma unroll
            for (int bj = 0; bj < 2; ++bj) { bb[bj][0] = *(const pg8::f32x4*)(bgg + cw + bj * 8); bb[bj][1] = *(const pg8::f32x4*)(bgg + cw + bj * 8 + 4); }
#pragma unroll
            for (int ai = 0; ai < 2; ++ai)
#pragma unroll
                for (int m = 0; m < 4; ++m) { bf16_t* rowp = (bf16_t*)LA + (size_t)(row0 - 8 * (fr >> 3) + ai * 128 + m * 16) * 256 + cw + 8 * (fr >> 3); pg8::u32x4 w[2];
#pragma unroll
                    for (int bj = 0; bj < 2; ++bj) { pg8::f32x4 v0 = acc[ai][bj][m][0] + bb[bj][0], v1 = acc[ai][bj][m][1] + bb[bj][1];
#pragma unroll
                        for (int j = 0; j < 4; ++j) { v0[j] = (fminf(v0[j], 0.f) - __logf(1.0f + __expf(-fabsf(v0[j])))) * (1.0f / 16.0f); v1[j] = (fminf(v1[j], 0.f) - __logf(1.0f + __expf(-fabsf(v1[j])))) * (1.0f / 16.0f); }
                        w[bj] = pg8::pack8(v0, v1); }
                    pg8::st_rows16(rowp, (size_t)8 * 256, w[0], w[1], fr >= 8); }
        }
    }
};
struct PleProb {
    static constexpr bool LIST_DMA = false, PERM64 = true, EPI_DMA = false, PERM = true, F8 = true, GATHER = true; static constexpr int SCALE_A = 0x7C7C7C7C, SCALE_B = 0x7C7C7C7C;
    static constexpr int K = 128; const unsigned char* A; const unsigned char* Bt; pg8::StaticOrder ord; bf16_t* PPRE; float* SSQP;
    int i0 = 0, n = 4;
    __device__ __forceinline__ bool next(int i, Unit& u) const { if (ord.G != 256) return (i0 == 0) && ord.next(i, u); if (ord.c < 128 && i < n) return ord.at((long)(i0 + i) * 128 + ord.c, u); return false; }
    __device__ __forceinline__ const char* a_base(const Unit&) const { return (const char*)A; }
    __device__ __forceinline__ void a_offs(const Unit& u, int tid, unsigned (&o)[2][2]) const {
#pragma unroll
        for (int i = 0; i < 2; ++i) { int R, C; pg8::stage_rc(tid * 16 + i * 8192, R, C);
#pragma unroll
            for (int h = 0; h < 2; ++h) o[h][i] = (unsigned)((u.pm * 256 + h * 128 + R) * K + C) * 2u; } }
    __device__ __forceinline__ const char* b_base(const Unit& u) const { return (const char*)Bt + (size_t)u.pn * 256 * K * 2; }
    __device__ __forceinline__ void epilogue(const pg8::f32x4 (&acc)[2][2][4][2], const Unit& u, int wr, int wc, int fr, int fq) const {
        const int row0 = u.pm * 256 + wr * 64 + fr, cw = u.pn * 256 + wc * 64 + 16 * fq;
#pragma unroll
        for (int ai = 0; ai < 2; ++ai) { float ssel = 0.f;
#pragma unroll
            for (int m = 0; m < 4; ++m) { const int row = row0 + ai * 128 + m * 16; unsigned char* rowp = (unsigned char*)PPRE + (size_t)row * 1024 + cw; float ss = 0.f; pg8::u32x4 w8;
#pragma unroll
                for (int bj = 0; bj < 2; ++bj) { const pg8::f32x4 v0 = acc[ai][bj][m][0], v1 = acc[ai][bj][m][1];
                    ss += (v0[0] * v0[0] + v0[1] * v0[1]) + (v0[2] * v0[2] + v0[3] * v0[3]) + (v1[0] * v1[0] + v1[1] * v1[1]) + (v1[2] * v1[2] + v1[3] * v1[3]);
                    w8[2 * bj] = pg8::pk4_fp8(v0[0] * 16.0f, v0[1] * 16.0f, v0[2] * 16.0f, v0[3] * 16.0f); w8[2 * bj + 1] = pg8::pk4_fp8(v1[0] * 16.0f, v1[1] * 16.0f, v1[2] * 16.0f, v1[3] * 16.0f); }
                *(pg8::u32x4*)rowp = w8;
                ss += __shfl_xor(ss, 16); ss += __shfl_xor(ss, 32);
                ssel = (fq == m) ? ss : ssel; }
            SSQP[(size_t)(row0 + ai * 128 + fq * 16) * 16 + u.pn * 4 + wc] = ssel; }
    }
};

struct OutProb {
    static constexpr bool LIST_DMA = false, PERM64 = true, EPI_DMA = false, PERM = true, F8 = true, GATHER = true; static constexpr int SCALE_A = 0x7C7C7C7C, SCALE_B = 0x7C7C7C7C;
    static constexpr int K = 512; const unsigned char* A; const unsigned char* Bt; pg8::StaticOrder ord; const float* X; bf16_t* H1; unsigned char* H1F8; float* SSQ;
    __device__ __forceinline__ bool next(int i, Unit& u) const { return ord.next(i, u); }
    __device__ __forceinline__ const char* a_base(const Unit&) const { return (const char*)A; }
    __device__ __forceinline__ void a_offs(const Unit& u, int tid, unsigned (&o)[2][2]) const {
#pragma unroll
        for (int i = 0; i < 2; ++i) { int R, C; pg8::stage_rc(tid * 16 + i * 8192, R, C);
#pragma unroll
            for (int h = 0; h < 2; ++h) o[h][i] = (unsigned)((u.pm * 256 + h * 128 + R) * K + C) * 2u; } }
    __device__ __forceinline__ const char* b_base(const Unit& u) const { return (const char*)Bt + (size_t)u.pn * 256 * K * 2; }
    __device__ __forceinline__ void epilogue(const pg8::f32x4 (&acc)[2][2][4][2], const Unit& u, int wr, int wc, int fr, int fq) const {
        const int row0 = u.pm * 256 + wr * 64 + fr, cw = u.pn * 256 + wc * 64 + 16 * fq;
#pragma unroll
        for (int ai = 0; ai < 2; ++ai) { float ssel = 0.f;
#pragma unroll
            for (int m = 0; m < 4; ++m) { const int row = row0 + ai * 128 + m * 16; const size_t off = (size_t)row * 1024 + cw; float ss = 0.f; pg8::u32x4 w8; pg8::u32x4 w[2];
#pragma unroll
                for (int bj = 0; bj < 2; ++bj) { const pg8::f32x4 x0 = *(const pg8::f32x4*)(X + off + bj * 8), x1 = *(const pg8::f32x4*)(X + off + bj * 8 + 4);
                    const pg8::f32x4 v0 = acc[ai][bj][m][0] + x0, v1 = acc[ai][bj][m][1] + x1;
                    ss += (v0[0] * v0[0] + v0[1] * v0[1]) + (v0[2] * v0[2] + v0[3] * v0[3]) + (v1[0] * v1[0] + v1[1] * v1[1]) + (v1[2] * v1[2] + v1[3] * v1[3]);
                    w[bj] = pg8::pack8(v0, v1);
                    w8[2 * bj] = pg8::pk4_fp8(v0[0], v0[1], v0[2], v0[3]); w8[2 * bj + 1] = pg8::pk4_fp8(v1[0], v1[1], v1[2], v1[3]); }
                pg8::st_rows16(H1 + off - (size_t)(8 * (fr >> 3)) * 1024 + 8 * (fr >> 3), (size_t)8 * 1024, w[0], w[1], fr >= 8);
                *(pg8::u32x4*)(H1F8 + off) = w8;
                ss += __shfl_xor(ss, 16); ss += __shfl_xor(ss, 32);
                ssel = (fq == m) ? ss : ssel; }
            SSQ[(size_t)(row0 + ai * 128 + fq * 16) * 16 + (u.pn & 3) * 4 + wc] = ssel; }
    }
};

typedef short bf16x8_t __attribute__((ext_vector_type(8)));
__device__ __forceinline__ void router_phase(Frame& F) {
    const bf16_t* H1 = (const bf16_t*)(F.ws + WS_H1); const bf16_t* WR = (const bf16_t*)(F.ws + WS_WR); const float* SSQ = (const float*)(F.ws + WS_SSQ_H1);
    int* LIST = (int*)(F.ws + WS_LIST); float* RLIST = (float*)(F.ws + WS_RLIST); float* GLIST = (float*)(F.ws + WS_GLIST); int* TOPE = (int*)(F.ws + WS_TOPE); int* TPOS = (int*)(F.ws + WS_TPOS);
    unsigned* CNT = (unsigned*)(F.ctl + CW_CNT); const float* SSQP = (const float*)(F.ws + WS_SSQ_PLE); float* RPLE = (float*)(F.ws + WS_RPLE);
    LAS float* lg = (LAS float*)(F.lds + RING_OFF + 66560 + F.wave * 4096);
    {
#pragma unroll
        for (int q = 0; q < 8; ++q) { const int c = F.wave * 8 + q, row = c >> 1, half = c & 1;
            __builtin_amdgcn_global_load_lds((const unsigned*)(WR + (size_t)row * 1024 + half * 512 + mk_lane_id() * 8), (LAS unsigned*)(F.lds + RING_OFF + row * 2064 + half * 1024), 16, 0, 0); }
        VM_WAIT(); __syncthreads();
    }
    const LAS unsigned char* wl0 = (const LAS unsigned char*)(F.lds + RING_OFF);
    volatile LAS unsigned* hist = (volatile LAS unsigned*)(F.lds + TAB_OFF + 512); volatile LAS unsigned* base = (volatile LAS unsigned*)(F.lds + TAB_OFF + 768);
    const int lane = mk_lane_id(), i = lane & 15, g = lane >> 4;
    const int nrounds = (T / 16 + F.G * NWAVES - 1) / (F.G * NWAVES);
    for (int rd = 0; rd < nrounds; ++rd) {
        const int item = (rd * F.G + F.vcu) * NWAVES + F.wave; const bool live = item < T / 16; const int t0 = item * 16;
        if ((F.wave * 64 + mk_lane_id()) < 32) hist[(F.wave * 64 + mk_lane_id())] = 0u;
        __syncthreads();
        int te[4] = {0, 0, 0, 0}; float tg[4] = {0.f, 0.f, 0.f, 0.f}; float rt = 0.f; unsigned lr[4] = {0u, 0u, 0u, 0u};
        if (live) {
            pg8::f32x4 a0 = (pg8::f32x4){0.f, 0.f, 0.f, 0.f}, a1 = a0;
            const bf16_t* ap = H1 + (size_t)(t0 + i) * 1024 + 8 * g; const bf16_t* b0 = WR + (size_t)i * 1024 + 8 * g; const bf16_t* b1 = WR + (size_t)(16 + i) * 1024 + 8 * g;
            bf16x8_t avr[32];
#pragma unroll
            for (int ks = 0; ks < 32; ++ks) avr[ks] = *(const bf16x8_t*)(ap + 32 * ks);
            __builtin_amdgcn_sched_barrier(0);
#pragma unroll
            for (int ks = 0; ks < 32; ++ks) { const bf16x8_t bv0 = *(const LAS bf16x8_t*)(wl0 + i * 2064 + (8 * g + 32 * ks) * 2), bv1 = *(const LAS bf16x8_t*)(wl0 + (16 + i) * 2064 + (8 * g + 32 * ks) * 2);
                a0 = __builtin_amdgcn_mfma_f32_16x16x32_bf16(avr[ks], bv0, a0, 0, 0, 0); a1 = __builtin_amdgcn_mfma_f32_16x16x32_bf16(avr[ks], bv1, a1, 0, 0, 0); }
#pragma unroll
            for (int r = 0; r < 4; ++r) { lg[(4 * g + r) * 33 + i] = a0[r]; lg[(4 * g + r) * 33 + 16 + i] = a1[r]; }
            LDS_WAIT(); asm volatile("" ::: "memory");
            if (lane < 16) {
                const int t = t0 + lane; float ss = 0.f;
#pragma unroll
                for (int q = 0; q < 4; ++q) { const f32x4 v = *(const f32x4*)(SSQ + (size_t)t * 16 + 4 * q); ss += (v.x + v.y) + (v.z + v.w); }
                rt = 1.0f / sqrtf(ss * (1.0f / 1024.0f) + EPS);
                { float sp = 0.f;
#pragma unroll
                  for (int q = 0; q < 4; ++q) { const f32x4 v = *(const f32x4*)(SSQP + (size_t)t * 16 + 4 * q); sp += (v.x + v.y) + (v.z + v.w); }
                  RPLE[t] = 1.0f / sqrtf(sp * (1.0f / 1024.0f) + EPS); }
                float v[32];
#pragma unroll
                for (int e = 0; e < 32; ++e) v[e] = lg[lane * 33 + e] * rt + INP(10)[e];
                unsigned used = 0u; float tv[4];
#pragma unroll
                for (int j = 0; j < 4; ++j) { float best = -INFINITY; int bi = 0;
#pragma unroll
                    for (int e = 0; e < 32; ++e) { const bool ok = !((used >> e) & 1u) && v[e] > best; best = ok ? v[e] : best; bi = ok ? e : bi; }
                    used |= 1u << bi; tv[j] = best; te[j] = bi; }
                const float e1 = __expf(tv[1] - tv[0]), e2 = __expf(tv[2] - tv[0]), e3 = __expf(tv[3] - tv[0]), inv = 1.0f / (1.0f + e1 + e2 + e3);
                tg[0] = inv; tg[1] = e1 * inv; tg[2] = e2 * inv; tg[3] = e3 * inv;
#pragma unroll
                for (int j = 0; j < 4; ++j) lr[j] = __hip_atomic_fetch_add((LAS unsigned*)&hist[te[j]], 1u, __ATOMIC_RELAXED, __HIP_MEMORY_SCOPE_WORKGROUP);
            }
        }
        __syncthreads();
        if ((F.wave * 64 + mk_lane_id()) < 32) { const unsigned h = hist[(F.wave * 64 + mk_lane_id())]; base[(F.wave * 64 + mk_lane_id())] = h ? __hip_atomic_fetch_add(CNT + 64 * (F.wave * 64 + mk_lane_id()), h, __ATOMIC_RELAXED, __HIP_MEMORY_SCOPE_AGENT) : 0u; }
        __syncthreads();
        if (live && lane < 16) { const int t = t0 + lane;
#pragma unroll
            for (int j = 0; j < 4; ++j) { const unsigned pos = base[te[j]] + lr[j]; const size_t li = (size_t)te[j] * T + pos;
                LIST[li] = t; RLIST[li] = rt; GLIST[li] = tg[j]; TOPE[t * 4 + j] = te[j]; TPOS[t * 4 + j] = (int)pos; } }
        __syncthreads();
    }
}
__device__ __forceinline__ void moe_tables(Frame& F) {
    volatile LAS int* tb = (volatile LAS int*)(F.lds + TAB_OFF); volatile LAS int* cn = (volatile LAS int*)(F.lds + TAB_OFF + 256);
    if ((F.wave * 64 + mk_lane_id()) < 32) cn[(F.wave * 64 + mk_lane_id())] = (int)__hip_atomic_load((unsigned*)(F.ctl + CW_CNT) + 64 * (F.wave * 64 + mk_lane_id()), __ATOMIC_RELAXED, __HIP_MEMORY_SCOPE_AGENT);
    __syncthreads();
    if ((F.wave * 64 + mk_lane_id()) == 0) { int acc = 0; for (int e = 0; e < 32; ++e) { tb[e] = acc; acc += (cn[e] + 255) >> 8; } tb[32] = acc; }
    __syncthreads();
}
struct MoeOrder {
    const LAS int* tb; const LAS int* cn; int NT, G, c; bool rev = false;
    __device__ __forceinline__ bool next(int i, Unit& u) const {
        const int L = i * G + c, lane = mk_lane_id(); int mtg = L / NT; const int pn = L - mtg * NT;
        const int tq = tb[lane < 32 ? lane : 32]; const int tot = __builtin_amdgcn_readlane(tq, 32);
        if (mtg >= tot) return false;
        if (rev) mtg = tot - 1 - mtg;
        const int e = (int)__popcll(__ballot(lane < 32 && mtg >= tq)) - 1;
        const int tbe = __builtin_amdgcn_readlane(tq, e), cne = __builtin_amdgcn_readfirstlane(cn[e]);
        u.pm = mtg; u.pn = pn; u.e = e; u.ml = mtg - tbe; u.nrows = min(256, cne - u.ml * 256); return true; }
};
typedef float f32x2_t __attribute__((ext_vector_type(2)));
__device__ __forceinline__ f32x2_t swiglu2(f32x2_t glu, f32x2_t lin) {
    f32x2_t g, l; g.x = fminf(glu.x, 7.0f); g.y = fminf(glu.y, 7.0f); l.x = __builtin_amdgcn_fmed3f(lin.x, -7.0f, 7.0f); l.y = __builtin_amdgcn_fmed3f(lin.y, -7.0f, 7.0f);
    const f32x2_t t = g * (-1.702f * 1.4426950408889634f);
    f32x2_t e; e.x = __builtin_amdgcn_exp2f(t.x); e.y = __builtin_amdgcn_exp2f(t.y);
    const f32x2_t d = e + 1.0f;
    f32x2_t r; r.x = __builtin_amdgcn_rcpf(d.x); r.y = __builtin_amdgcn_rcpf(d.y);
    const f32x2_t f = g * l + g;
    return r * f;
}
__device__ __forceinline__ float swiglu_f(float a, float b) { const float gl = fminf(a, 7.0f), ln = fminf(fmaxf(b, -7.0f), 7.0f); return gl * fast_sigm(1.702f * gl) * (ln + 1.0f); }
struct Moe1Prob {
    static constexpr bool LIST_DMA = true, PERM64 = true, EPI_DMA = true, PERM = true, F8 = true, GATHER = true; static constexpr int SCALE_A = 0x7C7C7C7C, SCALE_B = 0x7C7C7C7C;
    static constexpr int K = 512; const unsigned char* A; const unsigned char* Bt; MoeOrder ord; const int* LIST; const float* RLIST; const float* b1; unsigned char* HID; PG8_LAS unsigned char* ldsbase;
    __device__ __forceinline__ void epi_dma(const Unit& u, PG8_LAS unsigned char* lds, const int wid, const int lane) const {
        const float* src = (wid < 4) ? (RLIST + (size_t)u.e * T + u.ml * 256 + wid * 64 + lane) : (b1 + (size_t)u.e * 2048 + u.pn * 256 + (wid - 4) * 64 + lane);
        __builtin_amdgcn_global_load_lds((const unsigned*)src, (PG8_LAS unsigned*)(lds + pg8::STAGE_BYTES + 10240 + wid * 256), 4, 0, 0); }
    __device__ __forceinline__ bool next(int i, Unit& u) const { return ord.next(i, u); }
    __device__ __forceinline__ const char* a_base(const Unit&) const { return (const char*)A; }
    __device__ __forceinline__ void a_offs(const Unit& u, int tid, unsigned (&o)[2][2]) const {
#pragma unroll
        for (int i = 0; i < 2; ++i) { int R, C; pg8::stage_rc(tid * 16 + i * 8192, R, C);
#pragma unroll
            for (int h = 0; h < 2; ++h) { const int lr = min(h * 128 + R, u.nrows - 1); const int tok = LIST[(size_t)u.e * T + u.ml * 256 + lr]; o[h][i] = (unsigned)(tok * K + C) * 2u; } } }
    __device__ __forceinline__ const char* b_base(const Unit& u) const { return (const char*)Bt + ((size_t)u.e * 2048 + (size_t)u.pn * 256) * K * 2; }
    __device__ __forceinline__ void a_offs_dma(const Unit& u, PG8_LAS unsigned char* lds, const int wid, const int lane) const {
#pragma unroll
        for (int i = 0; i < 2; ++i) { int R, C; pg8::stage_rc((wid * 64 + lane) * 16 + i * 8192, R, C);
#pragma unroll
            for (int h = 0; h < 2; ++h) { const int lr = min(h * 128 + R, u.nrows - 1);
                __builtin_amdgcn_global_load_lds((const unsigned*)(LIST + (size_t)u.e * T + u.ml * 256 + lr), (PG8_LAS unsigned*)(lds + pg8::STAGE_BYTES + 2048 + ((h * 2 + i) * 8 + wid) * 256), 4, 0, 0); } } }
    __device__ __forceinline__ void a_offs_ld(PG8_LAS unsigned char* lds, const int wid, const int lane, unsigned (&o)[2][2]) const {
#pragma unroll
        for (int i = 0; i < 2; ++i) { int R, C; pg8::stage_rc((wid * 64 + lane) * 16 + i * 8192, R, C);
#pragma unroll
            for (int h = 0; h < 2; ++h) { const int tok = *(const PG8_LAS int*)(lds + pg8::STAGE_BYTES + 2048 + ((h * 2 + i) * 8 + wid) * 256 + lane * 4); o[h][i] = (unsigned)(tok * K + C) * 2u; } } }
    __device__ __forceinline__ void epilogue(const pg8::f32x4 (&acc)[2][2][4][2], const Unit& u, int wr, int wc, int fr, int fq) const {
        int lr0 = wr * 64 + fr; asm volatile("" : "+v"(lr0));
        const int cw = u.pn * 256 + wc * 64 + 16 * fq;
        const PG8_LAS float* rl = (const PG8_LAS float*)(ldsbase + pg8::STAGE_BYTES + 10240); const PG8_LAS float* bb = rl + 256 + wc * 64 + 16 * fq;
        pg8::f32x4 bv[2][2];
#pragma unroll
        for (int bj = 0; bj < 2; ++bj) { bv[bj][0] = *(const PG8_LAS pg8::f32x4*)(bb + bj * 8); bv[bj][1] = *(const PG8_LAS pg8::f32x4*)(bb + bj * 8 + 4); }
        const int odd = fq & 1;
#pragma unroll
        for (int ai = 0; ai < 2; ++ai)
#pragma unroll
            for (int mp = 0; mp < 2; ++mp) { pg8::u32x2 w2[2];
#pragma unroll
                for (int q = 0; q < 2; ++q) { const int m = 2 * mp + q; const float rs = rl[lr0 + ai * 128 + m * 16];
#pragma unroll
                    for (int bj = 0; bj < 2; ++bj) { const pg8::f32x4 v0 = acc[ai][bj][m][0] * rs + bv[bj][0], v1 = acc[ai][bj][m][1] * rs + bv[bj][1];
                        const f32x2_t s0 = swiglu2((f32x2_t){v0[0], v0[2]}, (f32x2_t){v0[1], v0[3]}), s1 = swiglu2((f32x2_t){v1[0], v1[2]}, (f32x2_t){v1[1], v1[3]});
                        w2[q][bj] = pg8::pk4_fp8(s0.x, s0.y, s1.x, s1.y); } }
                { auto r0 = __builtin_amdgcn_permlane16_swap(w2[0].x, w2[1].x, false, false); w2[0].x = r0[0]; w2[1].x = r0[1];
                  auto r1 = __builtin_amdgcn_permlane16_swap(w2[0].y, w2[1].y, false, false); w2[0].y = r1[0]; w2[1].y = r1[1]; }
                const int lr = lr0 + ai * 128 + (2 * mp + odd) * 16;
                if (lr < u.nrows) *(pg8::u32x4*)(HID + ((unsigned)(u.pm * 256 + lr) * 1024u + (unsigned)((cw >> 1) - 8 * odd))) = (pg8::u32x4){w2[0].x, w2[0].y, w2[1].x, w2[1].y}; }
    }
};
struct Moe2Prob {
    static constexpr bool LIST_DMA = false, PERM64 = true, EPI_DMA = true, PERM = true, F8 = MOE2_F8, GATHER = true;     static constexpr int SCALE_A = 0x7C7C7C7C, SCALE_B = 0x7C7C7C7C;
    static constexpr int K = 512; const unsigned char* A; const unsigned char* Bt; MoeOrder ord; const float* GLIST; const float* b2; unsigned char* Y; PG8_LAS unsigned char* ldsbase;
    __device__ __forceinline__ bool next(int i, Unit& u) const { return ord.next(i, u); }
    __device__ __forceinline__ const char* a_base(const Unit&) const { return (const char*)A; }
    __device__ __forceinline__ void a_offs(const Unit& u, int tid, unsigned (&o)[2][2]) const {
#pragma unroll
        for (int i = 0; i < 2; ++i) { int R, C; pg8::stage_rc(tid * 16 + i * 8192, R, C);
#pragma unroll
            for (int h = 0; h < 2; ++h) o[h][i] = (unsigned)((u.pm * 256 + h * 128 + R) * K + C) * 2u; } }
    __device__ __forceinline__ const char* b_base(const Unit& u) const { return (const char*)Bt + ((size_t)u.e * 1024 + (size_t)u.pn * 256) * K * 2; }
    __device__ __forceinline__ void epi_dma(const Unit& u, PG8_LAS unsigned char* lds, const int wid, const int lane) const {
        const float* src = (wid < 4) ? (GLIST + (size_t)u.e * T + u.ml * 256 + wid * 64 + lane) : (b2 + (size_t)u.e * 1024 + u.pn * 256 + (wid - 4) * 64 + lane);
        __builtin_amdgcn_global_load_lds((const unsigned*)src, (PG8_LAS unsigned*)(lds + pg8::STAGE_BYTES + 10240 + wid * 256), 4, 0, 0); }
    __device__ __forceinline__ void epilogue(const pg8::f32x4 (&acc)[2][2][4][2], const Unit& u, int wr, int wc, int fr, int fq) const {
        int lr0 = wr * 64 + fr; asm volatile("" : "+v"(lr0));
        const int cw = u.pn * 256 + wc * 64 + 16 * fq;
        const PG8_LAS float* gl = (const PG8_LAS float*)(ldsbase + pg8::STAGE_BYTES + 10240); const PG8_LAS float* bb = gl + 256 + wc * 64 + 16 * fq;
        pg8::f32x4 bv[2][2];
#pragma unroll
        for (int bj = 0; bj < 2; ++bj) { bv[bj][0] = *(const PG8_LAS pg8::f32x4*)(bb + bj * 8); bv[bj][1] = *(const PG8_LAS pg8::f32x4*)(bb + bj * 8 + 4); }
#pragma unroll
        for (int ai = 0; ai < 2; ++ai)
#pragma unroll
            for (int m = 0; m < 4; ++m) { const int lr = lr0 + ai * 128 + m * 16; { const float gt = gl[lr] * 16.0f; unsigned char* rowp = Y + ((unsigned)(u.pm * 256 + lr) * 1024u + (unsigned)cw);
                pg8::u32x4 w8;
#pragma unroll
                for (int bj = 0; bj < 2; ++bj) { const pg8::f32x4 v0 = (acc[ai][bj][m][0] + bv[bj][0]) * gt, v1 = (acc[ai][bj][m][1] + bv[bj][1]) * gt;
                    w8[2 * bj] = pg8::pk4_fp8(v0[0], v0[1], v0[2], v0[3]); w8[2 * bj + 1] = pg8::pk4_fp8(v1[0], v1[1], v1[2], v1[3]); }
                *(pg8::u32x4*)rowp = w8; } }
    }
};
__device__ __forceinline__ void combine_phase(Frame& F) {
    const volatile LAS int* tb = (const volatile LAS int*)(F.lds + TAB_OFF);
    const bf16_t* H = (const bf16_t*)(F.ws + WS_H1); bf16_t* H2o = (bf16_t*)(F.ws + WS_H2); unsigned char* H8 = F.ws + WS_H2F8; const unsigned char* Y = F.ws + WS_Y; const int* TOPE = (const int*)(F.ws + WS_TOPE); const int* TPOS = (const int*)(F.ws + WS_TPOS);
    const int gw = F.vcu * NWAVES + F.wave, NGW = F.G * NWAVES, lane = mk_lane_id();
    typedef float f2v __attribute__((ext_vector_type(2)));
#pragma unroll 4
    for (int t = gw; t < T; t += NGW) {
        float a[16], ys[16];
        { const v4u h0 = __builtin_nontemporal_load((const v4u*)(H + (size_t)t * 1024 + lane * 16)), h1 = __builtin_nontemporal_load((const v4u*)(H + (size_t)t * 1024 + lane * 16 + 8));
          const unsigned hw[8] = {h0.x, h0.y, h0.z, h0.w, h1.x, h1.y, h1.z, h1.w};
#pragma unroll
          for (int q = 0; q < 8; ++q) { a[2 * q] = __uint_as_float(hw[q] << 16); a[2 * q + 1] = __uint_as_float(hw[q] & 0xffff0000u); } }
#pragma unroll
        for (int q = 0; q < 16; ++q) ys[q] = 0.f;
#pragma unroll
        for (int j = 0; j < 4; ++j) { const int e = TOPE[t * 4 + j], pos = TPOS[t * 4 + j]; const size_t row = (size_t)tb[e] * 256 + pos;
            const v4u y = __builtin_nontemporal_load((const v4u*)(Y + row * 1024 + lane * 16)); const unsigned yw[4] = {y.x, y.y, y.z, y.w};
#pragma unroll
            for (int q = 0; q < 4; ++q) { const f2v lo = __builtin_amdgcn_cvt_pk_f32_fp8((int)yw[q], false), hi = __builtin_amdgcn_cvt_pk_f32_fp8((int)yw[q], true);
                ys[4 * q] += lo[0]; ys[4 * q + 1] += lo[1]; ys[4 * q + 2] += hi[0]; ys[4 * q + 3] += hi[1]; } }
#pragma unroll
        for (int q = 0; q < 16; ++q) a[q] = __builtin_fmaf(ys[q], 0.0625f, a[q]);
        v4u o0, o1; o0.x = pk2(a[0], a[1]); o0.y = pk2(a[2], a[3]); o0.z = pk2(a[4], a[5]); o0.w = pk2(a[6], a[7]); o1.x = pk2(a[8], a[9]); o1.y = pk2(a[10], a[11]); o1.z = pk2(a[12], a[13]); o1.w = pk2(a[14], a[15]);
        *(v4u*)(H2o + (size_t)t * 1024 + lane * 16) = o0; *(v4u*)(H2o + (size_t)t * 1024 + lane * 16 + 8) = o1;
        v4u o8; o8.x = pg8::pk4_fp8(a[0], a[1], a[2], a[3]); o8.y = pg8::pk4_fp8(a[4], a[5], a[6], a[7]); o8.z = pg8::pk4_fp8(a[8], a[9], a[10], a[11]); o8.w = pg8::pk4_fp8(a[12], a[13], a[14], a[15]);
        *(v4u*)(H8 + (size_t)t * 1024 + lane * 16) = o8;
    }
}

struct GateProb {
    static constexpr bool LIST_DMA = false, PERM64 = true, EPI_DMA = false, PERM = true, F8 = true, GATHER = true; static constexpr int SCALE_A = 0x7C7C7C7C, SCALE_B = 0x7C7C7C7C;
    static constexpr int K = 512; const unsigned char* A; const unsigned char* Bt; const bf16_t* H2; pg8::StaticOrder ord; const bf16_t* PPRE; const float* RPLE; const float* g_ple; bf16_t* H3; float* SSQ;
    __device__ __forceinline__ bool next(int i, Unit& u) const { if (!ord.next(i, u)) return false; u.pm = ord.nM - 1 - u.pm; return true; }
    __device__ __forceinline__ const char* a_base(const Unit&) const { return (const char*)A; }
    __device__ __forceinline__ void a_offs(const Unit& u, int tid, unsigned (&o)[2][2]) const {
#pragma unroll
        for (int i = 0; i < 2; ++i) { int R, C; pg8::stage_rc(tid * 16 + i * 8192, R, C);
#pragma unroll
            for (int h = 0; h < 2; ++h) o[h][i] = (unsigned)((u.pm * 256 + h * 128 + R) * K + C) * 2u; } }
    __device__ __forceinline__ const char* b_base(const Unit& u) const { return (const char*)Bt + (size_t)u.pn * 256 * K * 2; }
    __device__ __forceinline__ void epilogue(const pg8::f32x4 (&acc)[2][2][4][2], const Unit& u, int wr, int wc, int fr, int fq) const {
        int row0 = u.pm * 256 + wr * 64 + fr; asm volatile("" : "+v"(row0));
        const int cw = u.pn * 256 + wc * 64 + 16 * fq;
        pg8::f32x4 gv[2][2];
#pragma unroll
        for (int bj = 0; bj < 2; ++bj) { gv[bj][0] = *(const pg8::f32x4*)(g_ple + cw + bj * 8); gv[bj][1] = *(const pg8::f32x4*)(g_ple + cw + bj * 8 + 4); }
#pragma unroll
        for (int ai = 0; ai < 2; ++ai) { float ssel = 0.f;
#pragma unroll
            for (int m = 0; m < 4; ++m) { const int row = row0 + ai * 128 + m * 16; const unsigned off = ((unsigned)row * 1024u + (unsigned)cw) * 2u; const float rp = RPLE[row] * 0.0625f; float ss = 0.f; pg8::u32x4 w[2];
                const pg8::u32x4 p8 = *(const pg8::u32x4*)((const unsigned char*)PPRE + (size_t)row * 1024 + cw);
#pragma unroll
                for (int bj = 0; bj < 2; ++bj) {
                    const pg8::u32x4 hw = *(const pg8::u32x4*)((const char*)H2 + off + bj * 16);
                    typedef float f2v_ __attribute__((ext_vector_type(2)));
                    const f2v_ pa = __builtin_amdgcn_cvt_pk_f32_fp8((int)p8[2 * bj], false), pb = __builtin_amdgcn_cvt_pk_f32_fp8((int)p8[2 * bj], true), pc = __builtin_amdgcn_cvt_pk_f32_fp8((int)p8[2 * bj + 1], false), pd = __builtin_amdgcn_cvt_pk_f32_fp8((int)p8[2 * bj + 1], true);
                    const float pv[8] = {pa[0], pa[1], pb[0], pb[1], pc[0], pc[1], pd[0], pd[1]};
                    pg8::f32x4 v0, v1;
#pragma unroll
                    for (int q = 0; q < 2; ++q) { const float h_lo = __uint_as_float(hw[q] << 16), h_hi = __uint_as_float(hw[q] & 0xffff0000u), p_lo = pv[2 * q], p_hi = pv[2 * q + 1];
                        v0[2 * q] = h_lo + fast_sigm(acc[ai][bj][m][0][2 * q]) * (p_lo * rp * gv[bj][0][2 * q]); v0[2 * q + 1] = h_hi + fast_sigm(acc[ai][bj][m][0][2 * q + 1]) * (p_hi * rp * gv[bj][0][2 * q + 1]); }
#pragma unroll
                    for (int q = 0; q < 2; ++q) { const float h_lo = __uint_as_float(hw[2 + q] << 16), h_hi = __uint_as_float(hw[2 + q] & 0xffff0000u), p_lo = pv[4 + 2 * q], p_hi = pv[4 + 2 * q + 1];
                        v1[2 * q] = h_lo + fast_sigm(acc[ai][bj][m][1][2 * q]) * (p_lo * rp * gv[bj][1][2 * q]); v1[2 * q + 1] = h_hi + fast_sigm(acc[ai][bj][m][1][2 * q + 1]) * (p_hi * rp * gv[bj][1][2 * q + 1]); }
                    ss += (v0[0] * v0[0] + v0[1] * v0[1]) + (v0[2] * v0[2] + v0[3] * v0[3]) + (v1[0] * v1[0] + v1[1] * v1[1]) + (v1[2] * v1[2] + v1[3] * v1[3]);
                    w[bj] = pg8::pack8(v0, v1); }
                pg8::st_rows16((bf16_t*)((char*)H3 + off) - (8 * (fr >> 3)) * 1024 + 8 * (fr >> 3), (size_t)8 * 1024, w[0], w[1], fr >= 8);
                ss += __shfl_xor(ss, 16); ss += __shfl_xor(ss, 32);
                ssel = (fq == m) ? ss : ssel; }
            SSQ[(size_t)(row0 + ai * 128 + fq * 16) * 16 + (u.pn & 3) * 4 + wc] = ssel; }
    }
};
__device__ __forceinline__ void final_phase(Frame& F) {
    const bf16_t* H3 = (const bf16_t*)(F.ws + WS_H3); const float* SSQ = (const float*)(F.ws + WS_SSQ_H3);
    const int gw = F.vcu * NWAVES + F.wave, NGW = F.G * NWAVES, lane = mk_lane_id();
#pragma unroll 2
    for (int t = gw; t < T; t += NGW) {
        const float sv = (lane < 16) ? SSQ[(size_t)t * 16 + lane] : 0.f; float ss = sv;
        ss += __shfl_xor(ss, 1); ss += __shfl_xor(ss, 2); ss += __shfl_xor(ss, 4); ss += __shfl_xor(ss, 8);
        ss = __shfl(ss, 0);
        const float r = 1.0f / sqrtf(ss * (1.0f / 1024.0f) + EPS);
#pragma unroll
        for (int hf = 0; hf < 2; ++hf) { const v4u h = __builtin_nontemporal_load((const v4u*)(H3 + (size_t)t * 1024 + hf * 512 + lane * 8)); const float* gp = INP(18) + hf * 512 + lane * 8; float* op = ((float*)mk_karg(F.kp, 152)) + (size_t)t * 1024 + hf * 512 + lane * 8;
            const f32x4 g0 = *(const f32x4*)gp, g1 = *(const f32x4*)(gp + 4);
            f32x4 o0, o1; o0.x = __uint_as_float(h.x << 16) * r * g0.x; o0.y = __uint_as_float(h.x & 0xffff0000u) * r * g0.y; o0.z = __uint_as_float(h.y << 16) * r * g0.z; o0.w = __uint_as_float(h.y & 0xffff0000u) * r * g0.w;
            o1.x = __uint_as_float(h.z << 16) * r * g1.x; o1.y = __uint_as_float(h.z & 0xffff0000u) * r * g1.y; o1.z = __uint_as_float(h.w << 16) * r * g1.z; o1.w = __uint_as_float(h.w & 0xffff0000u) * r * g1.w;
            __builtin_nontemporal_store(o0, (f32x4*)op); __builtin_nontemporal_store(o1, (f32x4*)(op + 4)); }
    }
}

struct Args { const float* in[19]; float* out; unsigned char* ws; int ph_lo, ph_hi, li, pad; };
__global__ void __launch_bounds__(NWAVES * 64, 2) mk_fwd(Args args) {
    extern __shared__ __attribute__((aligned(16))) unsigned char lds[];
    Frame F;
    F.lds = (LAS unsigned char*)lds; F.MISC = (volatile LAS unsigned*)(F.lds + MISC_OFF);
    F.wave = __builtin_amdgcn_readfirstlane((int)threadIdx.x >> 6);
    F.G = gridDim.x; { const int bx = blockIdx.x; F.vcu = (F.G % 8 == 0) ? (bx % 8) * (F.G / 8) + bx / 8 : bx; }
    F.ws = args.ws; F.ctl = (gu32*)(args.ws + WS_CTL); F.kp = (kptr_t)__builtin_amdgcn_kernarg_segment_ptr();
    for (int u = (int)threadIdx.x; u < (LDS_BYTES - LDSCTL_OFF) / 4; u += NWAVES * 64) ((LAS unsigned*)(F.lds + LDSCTL_OFF))[u] = 0u;
    __syncthreads();
    const int lo = args.ph_lo, hi = args.ph_hi;
    const bool multi = (hi - lo) > 1;
    XcdBarrier bar; bar.bar = (unsigned*)(F.ctl + CW_BAR) + args.li * XCD_BAR_WORDS; bar.x = 0; bar.st = nullptr;
    if (multi) bar = xcd_barrier_post((unsigned*)(F.ctl + CW_BAR) + args.li * XCD_BAR_WORDS, F.MISC + 8, F.wave == 0 && mk_lane_id() == 0);
#ifndef PH_MASK
#define PH_MASK 0xFFF
#endif
#define IN(k) (((PH_MASK >> (k)) & 1) && lo <= (k) && (k) < hi)
#define SEAM(k) do { if (IN(k) && IN((k) + 1)) xcd_barrier(bar, F.wave == 0 && mk_lane_id() == 0); } while (0)
    if (IN(0)) { p0_prologue(F, args.pad); SEAM(0); }
    if (IN(1)) {
        const int ple_first = ((int)blockIdx.x < 64) ? 2 : ((int)blockIdx.x < 128) ? 1 : 0;
        { PleProb P; P.A = F.ws + WS_PB; P.Bt = F.ws + WS_WPP; P.ord.init(T, 1024, F.G, (int)blockIdx.x);
          P.PPRE = (bf16_t*)(F.ws + WS_PPRE); P.SSQP = (float*)(F.ws + WS_SSQ_PLE); P.i0 = 0; P.n = ple_first;
          if (ple_first > 0) pg8::gemm_phase<PleProb>(F.lds + RING_OFF, P, F.wave); }
        { ProjProb P; P.A = (const bf16_t*)(F.ws + WS_XN); P.Bt = (const bf16_t*)(F.ws + WS_WIN); P.ord.init(T, NPROJ, F.G, (int)blockIdx.x);
          P.ws = F.ws; P.LA = (float*)(F.ws + WS_LA); P.KMEAN = (float*)(F.ws + WS_KMEAN); P.bgg = INP(5);
          if (!DBG_NOPROJ) pg8::gemm_phase<ProjProb>(F.lds + RING_OFF, P, F.wave); }
        { PleProb P; P.A = F.ws + WS_PB; P.Bt = F.ws + WS_WPP; P.ord.init(T, 1024, F.G, (int)blockIdx.x);
          P.PPRE = (bf16_t*)(F.ws + WS_PPRE); P.SSQP = (float*)(F.ws + WS_SSQ_PLE); P.i0 = ple_first; P.n = 4 - ple_first;
          if (!DBG_NOPLE) pg8::gemm_phase<PleProb>(F.lds + RING_OFF, P, F.wave); }
        SEAM(1);
    }
    const gla::lptr wl = (gla::lptr)(F.lds + RING_OFF + F.wave * 16384);
    const gla::lptr wsc = (gla::lptr)(F.lds + 133120 + F.wave * 1024);
    const int gw = F.vcu * NWAVES + F.wave, NGW = F.G * NWAVES;
    if (IN(2)) {
        const gla::Tensors GT{(const bf16_t*)(F.ws + WS_QG), (const bf16_t*)(F.ws + WS_KG), (const bf16_t*)(F.ws + WS_VG), (const bf16_t*)(F.ws + WS_RGS), (const bf16_t*)(F.ws + WS_LA),
                              (bf16_t*)(F.ws + WS_KVS), (float*)(F.ws + WS_DEC), INP(6), (bf16_t*)(F.ws + WS_MIX)};
        const attn_body::AttnTensors AT{(const char*)F.ws, (long)WS_QA, (long)WS_KA, (long)WS_VA, (long)WS_MIX, (long)WS_KMEAN};
        const attn_body::StaticOrder S((int)F.G, (int)blockIdx.x);
#ifndef DBG_NOATTN
        attn_body::attn_phase<attn_body::StaticOrder>((char*)lds + RING_OFF, AT, S, F.wave);
#endif
        __syncthreads();
#ifndef DBG_NOGLAA
        for (int u = gw; u < 2048; u += NGW) gla::unit_a(GT, u, wl, wsc, mk_lane_id());
#endif
        SEAM(2);
    }
    if (IN(3)) {
        const gla::Tensors GT{(const bf16_t*)(F.ws + WS_QG), (const bf16_t*)(F.ws + WS_KG), (const bf16_t*)(F.ws + WS_VG), (const bf16_t*)(F.ws + WS_RGS), (const bf16_t*)(F.ws + WS_LA),
                              (bf16_t*)(F.ws + WS_KVS), (float*)(F.ws + WS_DEC), INP(6), (bf16_t*)(F.ws + WS_MIX)};
        for (int it = gw; it < 1024; it += NGW) gla::scan_item(GT, it, mk_lane_id()); SEAM(3); }
    if (IN(4)) {
        const gla::Tensors GT{(const bf16_t*)(F.ws + WS_QG), (const bf16_t*)(F.ws + WS_KG), (const bf16_t*)(F.ws + WS_VG), (const bf16_t*)(F.ws + WS_RGS), (const bf16_t*)(F.ws + WS_LA),
                              (bf16_t*)(F.ws + WS_KVS), (float*)(F.ws + WS_DEC), INP(6), (bf16_t*)(F.ws + WS_MIX)};
        for (int u = gw; u < 2048; u += NGW) gla::unit_c(GT, u, wl, mk_lane_id()); SEAM(4); }
    if (IN(5)) {
        OutProb P; P.A = F.ws + WS_MIX; P.Bt = F.ws + WS_WOUT; P.ord.init(T, 1024, F.G, (int)blockIdx.x);
        P.X = INP(0); P.H1 = (bf16_t*)(F.ws + WS_H1); P.H1F8 = F.ws + WS_H1F8; P.SSQ = (float*)(F.ws + WS_SSQ_H1);
        pg8::gemm_phase<OutProb>(F.lds + RING_OFF, P, F.wave);
        SEAM(5);
    }
    if (IN(6)) { router_phase(F); SEAM(6); }
    if (IN(7)) {
        moe_tables(F);
        Moe1Prob P; P.A = F.ws + WS_H1F8; P.Bt = F.ws + WS_W1;
        P.ord.tb = (const LAS int*)(F.lds + TAB_OFF); P.ord.cn = (const LAS int*)(F.lds + TAB_OFF + 256); P.ord.NT = 8; P.ord.G = F.G; P.ord.c = F.vcu;
        P.LIST = (const int*)(F.ws + WS_LIST); P.RLIST = (const float*)(F.ws + WS_RLIST); P.b1 = INP(12); P.HID = F.ws + WS_HID; P.ldsbase = F.lds + RING_OFF;
        pg8::gemm_phase<Moe1Prob>(F.lds + RING_OFF, P, F.wave);
        SEAM(7);
    }
    if (IN(8)) {
        moe_tables(F);
        Moe2Prob P; P.A = F.ws + WS_HID; P.Bt = F.ws + WS_W2;
        P.ord.tb = (const LAS int*)(F.lds + TAB_OFF); P.ord.cn = (const LAS int*)(F.lds + TAB_OFF + 256); P.ord.NT = 4; P.ord.G = F.G; P.ord.c = F.vcu; P.ord.rev = true;
        P.GLIST = (const float*)(F.ws + WS_GLIST); P.b2 = INP(14); P.Y = F.ws + WS_Y; P.ldsbase = F.lds + RING_OFF;
        pg8::gemm_phase<Moe2Prob>(F.lds + RING_OFF, P, F.wave);
        SEAM(8);
    }
    if (IN(9)) { moe_tables(F); combine_phase(F); SEAM(9); }
    if (IN(10)) {
        GateProb P; P.A = F.ws + WS_H2F8; P.Bt = F.ws + WS_WPG; P.H2 = (const bf16_t*)(F.ws + WS_H2); P.ord.init(T, 1024, F.G, (int)blockIdx.x);
        P.PPRE = (const bf16_t*)(F.ws + WS_PPRE); P.RPLE = (const float*)(F.ws + WS_RPLE); P.g_ple = INP(17); P.H3 = (bf16_t*)(F.ws + WS_H3); P.SSQ = (float*)(F.ws + WS_SSQ_H3);
        pg8::gemm_phase<GateProb>(F.lds + RING_OFF, P, F.wave);
        SEAM(10);
    }
    if (IN(11)) { final_phase(F); }
#undef IN
#undef SEAM
}
}

extern "C" void kernel_launch(void* const* d_in, const int* in_sizes, int n_in, void* d_out, int out_size, void* d_ws, size_t ws_size, hipStream_t stream) {
    using namespace nv;
    const float* x = (const float*)d_in[0]; const float* p = (const float*)d_in[1]; const float* g_mix = (const float*)d_in[2]; const float* w_in = (const float*)d_in[3];
    const float* w_gg = (const float*)d_in[4]; const float* b_gg = (const float*)d_in[5]; const float* g_gn = (const float*)d_in[6]; const float* w_out = (const float*)d_in[7];
    const float* g_ffn = (const float*)d_in[8]; const float* w_router = (const float*)d_in[9]; const float* b_router = (const float*)d_in[10]; const float* w1 = (const float*)d_in[11];
    const float* b1 = (const float*)d_in[12]; const float* w2 = (const float*)d_in[13]; const float* b2 = (const float*)d_in[14]; const float* w_pg = (const float*)d_in[15];
    const float* w_pp = (const float*)d_in[16]; const float* g_ple = (const float*)d_in[17]; const float* g_final = (const float*)d_in[18];
    (void)x; (void)w_out; (void)g_gn; (void)p; (void)g_ffn; (void)w_pg; (void)g_ple; (void)g_final; (void)w_router; (void)b_router; (void)w1; (void)b1; (void)w2; (void)b2; (void)g_mix; (void)w_in; (void)w_gg; (void)b_gg; (void)w_pp; (void)in_sizes; (void)out_size;
    float* out = (float*)d_out;
    constexpr size_t MiB = 1u << 20;
    static int grid = 0;
    if (grid == 0) {
        if (ws_size < 1024 * MiB || n_in != 19) { fprintf(stderr, "kernel_launch: unexpected ws_size %zu / n_in %d\n", ws_size, n_in); grid = -1; return; }
        int dev = 0, cus = 0, per_cu = 0;
        if (hipGetDevice(&dev) != hipSuccess || hipDeviceGetAttribute(&cus, hipDeviceAttributeMultiprocessorCount, dev) != hipSuccess) { grid = -1; return; }
        if (hipFuncSetAttribute((const void*)mk::mk_fwd, hipFuncAttributeMaxDynamicSharedMemorySize, mk::LDS_BYTES) != hipSuccess) { fprintf(stderr, "kernel_launch: hipFuncSetAttribute failed\n"); grid = -1; return; }
        if (hipOccupancyMaxActiveBlocksPerMultiprocessor(&per_cu, (const void*)mk::mk_fwd, mk::NWAVES * 64, mk::LDS_BYTES) != hipSuccess || per_cu < 1) { fprintf(stderr, "kernel_launch: occupancy query says %d\n", per_cu); (void)hipGetLastError(); per_cu = 1; }
        grid = cus;
    }
    if (grid < 0) return;
    char* ws = (char*)d_ws;
    (void)hipMemsetAsync(ws + mk::WS_CTL, 0, mk::CTL_ZERO_BYTES, stream);
    mk::Args a{};
    for (int i = 0; i < 19; ++i) a.in[i] = (const float*)d_in[i];
    a.out = out; a.ws = (unsigned char*)d_ws;
    auto launch_phases = [&](int lo, int hi) { a.ph_lo = lo; a.ph_hi = hi; hipLaunchKernelGGL(mk::mk_fwd, dim3(grid), dim3(mk::NWAVES * 64), mk::LDS_BYTES, stream, a); };
    (void)launch_phases;
    auto coop = [&](int lo, int hi, int li) { a.ph_lo = lo; a.ph_hi = hi; a.li = li; void* kargs[] = {(void*)&a};
        const hipError_t le = hipLaunchCooperativeKernel((const void*)mk::mk_fwd, dim3(grid), dim3(mk::NWAVES * 64), kargs, mk::LDS_BYTES, stream);
        if (le != hipSuccess) fprintf(stderr, "kernel_launch: cooperative launch failed: %s (grid %d)\n", hipGetErrorString(le), grid); };
#if PROBE_REP_PHASE >= 0
    coop(0, PROBE_REP_PHASE + 1, 0); coop(PROBE_REP_PHASE, mk::NPHASES, 1);
#else
    coop(0, mk::NPHASES, 0);
#endif
}
```
